# Optimizing an MI355X kernel written in HIP

```python
import jax, jax.numpy as jnp
from jax import lax
import numpy as np

D_MODEL = 1024
BATCH = 32
SEQ = 2048
DEPTH = 1

D_MIX = D_MODEL
SB_HEADS = 8
SB_HEAD_DIM = 64
SB_WIDTH = SB_HEADS * SB_HEAD_DIM
MLA_HEADS = 8
MLA_NOPE = 64
MLA_ROPE = 32
MLA_V = 64
MLA_WIDTH = MLA_HEADS * MLA_V
Q_LORA = 256
KV_LORA = 128
ROPE_BASE = 10000.0
Q_BLOCK = 128
SPLITS = (SB_WIDTH, 2 * SB_WIDTH, 3 * SB_WIDTH, 3 * SB_WIDTH + Q_LORA, 3 * SB_WIDTH + Q_LORA + KV_LORA)
IN_COLS = 3 * SB_WIDTH + Q_LORA + KV_LORA + MLA_ROPE
N_GROUPS = 4
EXPERTS_PER_GROUP = 8
N_EXPERTS = N_GROUPS * EXPERTS_PER_GROUP
TOP_K = 2
D_EXPERT = 256
EPS = 1e-6

kernel_name = "hybrid_sb_mla_hmoe_layer"


def _rmsnorm(x, g):
    x32 = x.astype(jnp.float32)
    y = x32 * lax.rsqrt(jnp.mean(x32 * x32, axis=-1, keepdims=True) + EPS)
    return y.astype(x.dtype) * g


def _rope(x, pos):
    half = x.shape[-1] // 2
    inv_freq = ROPE_BASE ** (-jnp.arange(half, dtype=jnp.float32) / half)
    ang = pos.astype(jnp.float32)[..., None] * inv_freq
    cos = jnp.cos(ang)[:, :, None, :].astype(x.dtype)
    sin = jnp.sin(ang)[:, :, None, :].astype(x.dtype)
    x1, x2 = x[..., :half], x[..., half:]
    return jnp.concatenate([x1 * cos - x2 * sin, x2 * cos + x1 * sin], axis=-1)


def _stick_breaking_attention(q, k, v):
    S = q.shape[2]
    scale = SB_HEAD_DIM ** -0.5
    outs = []
    for i in range(S // Q_BLOCK):
        q0 = i * Q_BLOCK
        kv_len = q0 + Q_BLOCK
        z = jnp.einsum('bhqd,bhkd->bhqk', q[:, :, q0:kv_len], k[:, :, :kv_len]).astype(jnp.float32) * scale
        t_idx = q0 + jnp.arange(Q_BLOCK)[:, None]
        s_idx = jnp.arange(kv_len)[None, :]
        strict = s_idx < t_idx
        log1m = jnp.where(strict, -jax.nn.softplus(z), 0.0)
        after = lax.cumsum(log1m, axis=log1m.ndim - 1, reverse=True) - log1m
        a = jnp.where(strict, jnp.exp(jax.nn.log_sigmoid(z) + after), 0.0)
        outs.append(jnp.einsum('bhqk,bhkd->bhqd', a.astype(v.dtype), v[:, :, :kv_len]))
    return jnp.concatenate(outs, axis=2)


def _causal_softmax_attention(q, k, v):
    S = q.shape[2]
    scale = q.shape[-1] ** -0.5
    outs = []
    for i in range(S // Q_BLOCK):
        q0 = i * Q_BLOCK
        kv_len = q0 + Q_BLOCK
        s = jnp.einsum('bhqd,bhkd->bhqk', q[:, :, q0:kv_len], k[:, :, :kv_len]).astype(jnp.float32) * scale
        causal = jnp.arange(kv_len)[None, :] <= (q0 + jnp.arange(Q_BLOCK)[:, None])
        p = jax.nn.softmax(jnp.where(causal, s, -jnp.inf), axis=-1)
        outs.append(jnp.einsum('bhqk,bhkd->bhqd', p.astype(v.dtype), v[:, :, :kv_len]))
    return jnp.concatenate(outs, axis=2)


def _mixer(h, positions, w_in, q_norm, w_uq, kv_norm, w_ukv, sb_out_norm, mla_out_norm, w_out):
    B, S, _ = h.shape
    proj = h @ w_in
    q_sb, k_sb, v_sb, c_q, c_kv, k_r = jnp.split(proj, SPLITS, axis=-1)
    heads = lambda t: t.reshape(B, S, SB_HEADS, SB_HEAD_DIM).transpose(0, 2, 1, 3)
    o_sb = _stick_breaking_attention(heads(q_sb), heads(k_sb), heads(v_sb))
    o_sb = o_sb.transpose(0, 2, 1, 3).reshape(B, S, SB_WIDTH)
    q = (_rmsnorm(c_q, q_norm) @ w_uq).reshape(B, S, MLA_HEADS, MLA_NOPE + MLA_ROPE)
    q = jnp.concatenate([q[..., :MLA_NOPE], _rope(q[..., MLA_NOPE:], positions)], axis=-1)
    kv = (_rmsnorm(c_kv, kv_norm) @ w_ukv).reshape(B, S, MLA_HEADS, MLA_NOPE + MLA_V)
    k_rope = jnp.broadcast_to(_rope(k_r[:, :, None, :], positions), (B, S, MLA_HEADS, MLA_ROPE))
    k = jnp.concatenate([kv[..., :MLA_NOPE], k_rope], axis=-1)
    v = kv[..., MLA_NOPE:]
    o_mla = _causal_softmax_attention(q.transpose(0, 2, 1, 3), k.transpose(0, 2, 1, 3), v.transpose(0, 2, 1, 3))
    o_mla = o_mla.transpose(0, 2, 1, 3).reshape(B, S, MLA_WIDTH)
    o = jnp.concatenate([_rmsnorm(o_sb, sb_out_norm), _rmsnorm(o_mla, mla_out_norm)], axis=-1)
    return o @ w_out


def _hierarchical_moe(h, w_group_router, b_group_router, w_expert_router, b_expert_router, w_gate, w_up, w_down):
    B, S, D = h.shape
    T = B * S
    tok = h.reshape(T, D)
    p_group = jax.nn.softmax((tok @ w_group_router + b_group_router).astype(jnp.float32), axis=-1)
    g_val, g_idx = lax.top_k(p_group, 1)
    g_val, g_idx = g_val[:, 0], g_idx[:, 0]
    e_logits = (tok @ w_expert_router + b_expert_router).astype(jnp.float32).reshape(T, N_GROUPS, EXPERTS_PER_GROUP)
    sel = jnp.broadcast_to(g_idx[:, None, None], (T, 1, EXPERTS_PER_GROUP))
    local = jnp.take_along_axis(e_logits, sel, axis=1)[:, 0]
    e_val, e_idx = lax.top_k(jax.nn.softmax(local, axis=-1), TOP_K)
    weights = g_val[:, None] * e_val / jnp.sum(e_val, axis=-1, keepdims=True)
    flat_e = (g_idx[:, None] * EXPERTS_PER_GROUP + e_idx).reshape(-1)
    flat_w = weights.reshape(-1)
    flat_tok = jnp.arange(T * TOP_K, dtype=jnp.int32) // TOP_K
    order = jnp.argsort(flat_e)
    tok_sorted = flat_tok[order]
    group_sizes = jnp.bincount(flat_e, length=N_EXPERTS).astype(jnp.int32)
    xs = tok[tok_sorted]
    hid = jax.nn.silu(lax.ragged_dot(xs, w_gate, group_sizes)) * lax.ragged_dot(xs, w_up, group_sizes)
    out = lax.ragged_dot(hid, w_down, group_sizes)
    y = jax.ops.segment_sum(out * flat_w[order][:, None].astype(out.dtype), tok_sorted, num_segments=T)
    return y.reshape(B, S, D).astype(h.dtype)


def setup_inputs(seed: int = 0) -> dict:
    key = jax.random.key(seed)
    ks = jax.random.split(key, 20)
    f32 = jnp.float32
    nrm = lambda k, shape, scale: jax.random.normal(k, shape, f32) * scale
    gain = lambda k, n: 1.0 + 0.02 * jax.random.normal(k, (DEPTH, n), f32)
    return {
        "x": jax.random.normal(ks[0], (BATCH, SEQ, D_MODEL), f32),
        "positions": jnp.broadcast_to(jnp.arange(SEQ, dtype=jnp.int32), (BATCH, SEQ)),
        "attn_norm": gain(ks[1], D_MODEL),
        "w_in": nrm(ks[2], (DEPTH, D_MODEL, IN_COLS), D_MODEL ** -0.5),
        "q_norm": gain(ks[3], Q_LORA),
        "w_uq": nrm(ks[4], (DEPTH, Q_LORA, MLA_HEADS * (MLA_NOPE + MLA_ROPE)), Q_LORA ** -0.5),
        "kv_norm": gain(ks[5], KV_LORA),
        "w_ukv": nrm(ks[6], (DEPTH, KV_LORA, MLA_HEADS * (MLA_NOPE + MLA_V)), KV_LORA ** -0.5),
        "sb_out_norm": gain(ks[7], SB_WIDTH),
        "mla_out_norm": gain(ks[8], MLA_WIDTH),
        "w_out": nrm(ks[9], (DEPTH, D_MIX, D_MODEL), D_MIX ** -0.5),
        "ffn_norm": gain(ks[10], D_MODEL),
        "w_group_router": nrm(ks[11], (DEPTH, D_MODEL, N_GROUPS), D_MODEL ** -0.5),
        "b_group_router": nrm(ks[12], (DEPTH, N_GROUPS), 0.01),
        "w_expert_router": nrm(ks[13], (DEPTH, D_MODEL, N_EXPERTS), D_MODEL ** -0.5),
        "b_expert_router": nrm(ks[14], (DEPTH, N_EXPERTS), 0.01),
        "w_gate": nrm(ks[15], (DEPTH, N_EXPERTS, D_MODEL, D_EXPERT), D_MODEL ** -0.5),
        "w_up": nrm(ks[16], (DEPTH, N_EXPERTS, D_MODEL, D_EXPERT), D_MODEL ** -0.5),
        "w_down": nrm(ks[17], (DEPTH, N_EXPERTS, D_EXPERT, D_MODEL), D_EXPERT ** -0.5),
        "final_norm": 1.0 + 0.02 * jax.random.normal(ks[18], (D_MODEL,), f32),
    }


def reference(x, positions, attn_norm, w_in, q_norm, w_uq, kv_norm, w_ukv, sb_out_norm, mla_out_norm,
              w_out, ffn_norm, w_group_router, b_group_router, w_expert_router, b_expert_router,
              w_gate, w_up, w_down, final_norm):
    for l in range(DEPTH):
        h = _rmsnorm(x, attn_norm[l])
        x = x + _mixer(h, positions, w_in[l], q_norm[l], w_uq[l], kv_norm[l], w_ukv[l],
                       sb_out_norm[l], mla_out_norm[l], w_out[l])
        h = _rmsnorm(x, ffn_norm[l])
        x = x + _hierarchical_moe(h, w_group_router[l], b_group_router[l], w_expert_router[l],
                                  b_expert_router[l], w_gate[l], w_up[l], w_down[l])
    return _rmsnorm(x, final_norm)
```

```cpp
#include <hip/hip_runtime.h>
#include <cstdio>
#include <cstdint>
#include <cmath>
namespace pg8 {
#define PG8_LAS __attribute__((address_space(3)))
typedef unsigned short bf16_t;
typedef short bf16x8 __attribute__((ext_vector_type(8)));
typedef float f32x4 __attribute__((ext_vector_type(4)));
typedef unsigned u32x4 __attribute__((ext_vector_type(4)));
constexpr int BM = 256, BK = 64, HALF = 128, HTB = HALF * BK * 2  , STAGE_BYTES = 8 * HTB, NXCD = 8, WGM = 8;

__host__ __device__ __forceinline__ int lds_byte(int r, int c) { const int st = (r >> 4) * 2 + (c >> 5), rr = r & 15, cc = c & 31, ob = rr * 64 + cc * 2; return st * 1024 + (ob ^ (((ob >> 9) & 1) << 5)); }
__host__ __device__ __forceinline__ void stage_rc(int b, int& R, int& C) { const int st = b / 1024, sb = b % 1024, swz = sb ^ (((sb >> 9) & 1) << 5); R = (st >> 1) * 16 + swz / 64; C = (st & 1) * 32 + (swz % 64) / 2; }
__host__ __device__ __forceinline__ int perm32(int rho) { const int n = rho >> 4, i = rho & 15; return 8 * (i >> 2) + 4 * n + (i & 3); }

struct Unit { int pm, pn; };
struct Gemm { const bf16_t* A; const bf16_t* Bt; int M, N, K; const int* rowtok; };

struct StaticOrder {
    int nM, nN, nwg, G, c;
    __host__ __device__ void init(int M, int N, int G_, int c_) { nM = M / BM; nN = N / BM; nwg = nM * nN; G = G_; c = c_; }
    __host__ __device__ bool next(int i, Unit& u) const {
        const long L = (long)i * G + c; if (L >= nwg) return false;
        int wgid = (int)L; { const int q = nwg / NXCD, r = nwg % NXCD, xcd = wgid % NXCD, off = wgid / NXCD; wgid = (xcd < r ? xcd * (q + 1) : r * (q + 1) + (xcd - r) * q) + off; }
        const int nig = WGM * nN, gid = wgid / nig, fm = gid * WGM, gsz = (nM - fm) < WGM ? (nM - fm) : WGM;
        u.pm = fm + ((wgid % nig) % gsz); u.pn = (wgid % nig) / gsz; return true;
    }
    __device__ __forceinline__ void a_ready(const Unit&) const {}
    __device__ __forceinline__ void done(const Unit&) const {}
};

typedef float f32x2_t __attribute__((ext_vector_type(2))); typedef __bf16 bf16x2_t __attribute__((ext_vector_type(2)));
__device__ __forceinline__ unsigned cvt_pk_bf16(float lo, float hi) { f32x2_t v = {lo, hi}; bf16x2_t b = __builtin_convertvector(v, bf16x2_t); return __builtin_bit_cast(unsigned, b); }

template <class Epi, class Sched, bool ALIGN_EPI, bool GATHER>
__device__ __forceinline__ void gemm_phase(PG8_LAS unsigned char* lds, const Gemm g, const Sched& S, const Epi& E) {
    const int tid = threadIdx.x, wid = __builtin_amdgcn_readfirstlane(tid >> 6), lane = tid & 63, wr = wid >> 2, wc = wid & 3, fr = lane & 15, fq = lane >> 4;
    const int K = g.K, nt = K / BK;
    unsigned voffA[2], voffB[2]; int RA[2], CA[2];
#pragma unroll
    for (int i = 0; i < 2; ++i) { int R, C; stage_rc(tid * 16 + i * 8192, R, C); const int Rb = Epi::PERM ? ((R & ~31) + perm32(R & 31)) : R;
        voffA[i] = (unsigned)(R * K + C) * 2u; voffB[i] = (unsigned)(Rb * K + C) * 2u; RA[i] = R; CA[i] = C; }
    const size_t kstep = (size_t)(BK * 2);
    const size_t hstep = (size_t)HALF * K * 2;
    const size_t tstep = 2 * hstep;
    const unsigned ldsw = (unsigned)wid * 1024u;
    const int aoff = lds_byte(wr * 64 + fr, fq * 8), boff = lds_byte(wc * 32 + fr, fq * 8);
#define PG8_SA(b, h) (((b) * 2 + (h)) * HTB)
#define PG8_SB(b, h) ((4 + (b) * 2 + (h)) * HTB)
#define PG8_STAGE(bufoff, gbase, voff) do { _Pragma("unroll") for (int _i = 0; _i < 2; ++_i) \
        __builtin_amdgcn_global_load_lds((const unsigned*)((const char*)(gbase) + (voff)[_i]), (PG8_LAS unsigned*)(lds + (bufoff) + ldsw + _i * 8192), 16, 0, 0); } while (0)
#define PG8_STAGE_A(b, h, p, OFF) do { if constexpr (GATHER) { PG8_STAGE(PG8_SA(b, h), (p), OFF[h]); } else { PG8_STAGE(PG8_SA(b, h), (p) + (h) * hstep, voffA); } } while (0)
#define PG8_LDA(dst, b, h) do { _Pragma("unroll") for (int m = 0; m < 4; ++m) _Pragma("unroll") for (int k = 0; k < 2; ++k) dst[m][k] = *(const PG8_LAS bf16x8*)(lds + PG8_SA(b, h) + aoff + m * 2048 + k * 1024); } while (0)
#define PG8_LDB(dst, b, h) do { _Pragma("unroll") for (int n = 0; n < 2; ++n) _Pragma("unroll") for (int k = 0; k < 2; ++k) dst[n][k] = *(const PG8_LAS bf16x8*)(lds + PG8_SB(b, h) + boff + n * 2048 + k * 1024); } while (0)
#define PG8_MMA(ai, bj, At, Bt) do { __builtin_amdgcn_s_setprio(1); _Pragma("unroll") for (int m = 0; m < 4; ++m) _Pragma("unroll") for (int n = 0; n < 2; ++n) _Pragma("unroll") for (int k = 0; k < 2; ++k) \
        acc[ai][bj][m][n] = __builtin_amdgcn_mfma_f32_16x16x32_bf16(Bt[n][k], At[m][k], acc[ai][bj][m][n], 0, 0, 0); __builtin_amdgcn_s_setprio(0); } while (0)
#define PG8_WAIT_V(n) asm volatile("s_waitcnt vmcnt(" #n ")" ::: "memory")
#define PG8_WAIT_L(n) asm volatile("s_waitcnt lgkmcnt(" #n ")" ::: "memory")
#define PG8_BAR __builtin_amdgcn_s_barrier()
#define PG8_SCHED __builtin_amdgcn_sched_barrier(0)
#define PG8_GOFF(dst, pm_) do { _Pragma("unroll") for (int _h = 0; _h < 2; ++_h) _Pragma("unroll") for (int _i = 0; _i < 2; ++_i) { \
        int _t = g.rowtok[(pm_) * BM + _h * HALF + RA[_i]]; _t = _t < 0 ? 0 : (_t >> 1); dst[_h][_i] = (unsigned)(_t * K + CA[_i]) * 2u; } } while (0)
    Unit cur, nxt; int ui = 0;
    if (!S.next(0, cur)) return;
    f32x4 acc[2][2][4][2];
#pragma unroll
    for (int a = 0; a < 2; ++a)
#pragma unroll
        for (int b = 0; b < 2; ++b)
#pragma unroll
            for (int m = 0; m < 4; ++m)
#pragma unroll
                for (int n = 0; n < 2; ++n) acc[a][b][m][n] = (f32x4){0.f, 0.f, 0.f, 0.f};
    bf16x8 At[4][2], B0[2][2], B1[2][2];
    unsigned oC[2][2] = {{0u, 0u}, {0u, 0u}}, oN[2][2] = {{0u, 0u}, {0u, 0u}}, o2[2][2] = {{0u, 0u}, {0u, 0u}};
    if constexpr (GATHER) { PG8_GOFF(oC, cur.pm); }
    const char* cA = GATHER ? (const char*)g.A : (const char*)g.A + (size_t)cur.pm * tstep; const char* cB = (const char*)g.Bt + (size_t)cur.pn * tstep;
    S.a_ready(cur);
    PG8_STAGE(PG8_SB(0, 0), cB, voffB); PG8_STAGE(PG8_SB(0, 1), cB + hstep, voffB); PG8_STAGE_A(0, 0, cA, oC); PG8_STAGE_A(0, 1, cA, oC);
    if (wr == 1) PG8_BAR;
    PG8_WAIT_V(2); PG8_BAR;
    PG8_STAGE(PG8_SB(1, 0), cB + kstep, voffB); PG8_STAGE_A(1, 0, cA + kstep, oC); PG8_STAGE(PG8_SB(1, 1), cB + hstep + kstep, voffB);
    PG8_WAIT_V(6); PG8_BAR;
    for (;;) {
        const bool has_next = S.next(ui + 1, nxt);
        if constexpr (GATHER) { if (has_next) { PG8_GOFF(oN, nxt.pm); } }
        const char* nA = GATHER ? cA : (has_next ? (const char*)g.A + (size_t)nxt.pm * tstep : cA); const char* nB = has_next ? (const char*)g.Bt + (size_t)nxt.pn * tstep : cB;
#pragma clang loop unroll(disable)
        for (int t = 0; t < nt; t += 2) {
            const bool last = (t == nt - 2);
            const char* a1 = cA + (size_t)(t + 1) * kstep;
            const char* a2 = last ? nA : cA + (size_t)(t + 2) * kstep; const char* b2 = last ? nB : cB + (size_t)(t + 2) * kstep;
            const char* a3 = a2 + kstep; const char* b3 = b2 + kstep;
            if constexpr (GATHER) { const bool sel = last && has_next;
#pragma unroll
                for (int h = 0; h < 2; ++h)
#pragma unroll
                    for (int i = 0; i < 2; ++i) o2[h][i] = sel ? oN[h][i] : oC[h][i]; }
            if (last && has_next) S.a_ready(nxt);
            PG8_LDB(B0, 0, 0); PG8_LDB(B1, 0, 1); PG8_SCHED; PG8_LDA(At, 0, 0); PG8_STAGE_A(1, 1, a1, oC);
            PG8_WAIT_V(8); PG8_WAIT_L(0); PG8_BAR; PG8_MMA(0, 0, At, B0); PG8_MMA(0, 1, At, B1); PG8_BAR; PG8_SCHED;
            PG8_LDA(At, 0, 1); PG8_STAGE(PG8_SB(0, 0), b2, voffB); PG8_STAGE(PG8_SB(0, 1), b2 + hstep, voffB); PG8_STAGE_A(0, 0, a2, o2);
            PG8_WAIT_V(8); PG8_WAIT_L(0); PG8_BAR; PG8_MMA(1, 0, At, B0); PG8_MMA(1, 1, At, B1); PG8_BAR; PG8_SCHED;
            PG8_LDB(B0, 1, 0); PG8_LDB(B1, 1, 1); PG8_SCHED; PG8_LDA(At, 1, 0); PG8_STAGE_A(0, 1, a2, o2);
            PG8_WAIT_V(8); PG8_WAIT_L(0); PG8_BAR; PG8_MMA(0, 0, At, B0); PG8_MMA(0, 1, At, B1); PG8_BAR; PG8_SCHED;
            PG8_LDA(At, 1, 1); PG8_STAGE(PG8_SB(1, 0), b3, voffB); PG8_STAGE(PG8_SB(1, 1), b3 + hstep, voffB); PG8_STAGE_A(1, 0, a3, o2);
            PG8_WAIT_V(8); PG8_WAIT_L(0); PG8_BAR; PG8_MMA(1, 0, At, B0); PG8_MMA(1, 1, At, B1); PG8_BAR; PG8_SCHED;
        }
        if constexpr (ALIGN_EPI) { if (wr == 0) PG8_BAR; }
        E(acc, cur, wr, wc, fr, fq); S.done(cur);
        if (!has_next) break;
#pragma unroll
        for (int a = 0; a < 2; ++a)
#pragma unroll
            for (int b = 0; b < 2; ++b)
#pragma unroll
                for (int m = 0; m < 4; ++m)
#pragma unroll
                    for (int n = 0; n < 2; ++n) acc[a][b][m][n] = (f32x4){0.f, 0.f, 0.f, 0.f};
        cur = nxt; cA = nA; cB = nB; ++ui;
        if constexpr (GATHER) {
#pragma unroll
            for (int h = 0; h < 2; ++h)
#pragma unroll
                for (int i = 0; i < 2; ++i) oC[h][i] = oN[h][i]; }
        if constexpr (ALIGN_EPI) { if (wr == 1) PG8_BAR; }
    }
    PG8_WAIT_V(0);
    if constexpr (!ALIGN_EPI) { if (wr == 0) PG8_BAR; }
    PG8_BAR;
#undef PG8_SA
#undef PG8_SB
#undef PG8_STAGE
#undef PG8_STAGE_A
#undef PG8_LDA
#undef PG8_LDB
#undef PG8_MMA
#undef PG8_WAIT_V
#undef PG8_WAIT_L
#undef PG8_BAR
#undef PG8_SCHED
#undef PG8_GOFF
}
}

constexpr int NWAVES = 8;
constexpr int BATCH = 32, SEQ = 2048, DM = 1024, T = BATCH * SEQ;
constexpr int NH = 8, HD = 64, SBW = 512, MLAW = 512, QLORA = 256, KVLORA = 128, ROPE = 32, NOPE = 64, QKD = 96;
constexpr int INC = 1952, INP = 2048;
constexpr int NEXP = 32, NGRP = 4, EPG = 8, DEXP = 256;
constexpr int MAXTILES = 544;
constexpr float EPS = 1e-6f;
constexpr float LOG2E = 1.4426950408889634f;
constexpr float SB_C2 = 0.125f * LOG2E;
constexpr float MLA_C2 = 0.10206207261596575f * LOG2E;

constexpr size_t MiB = 1u << 20;
constexpr size_t WS_CTL = 0, CTL_ZERO_BYTES = 1 * MiB;
constexpr size_t WS_WIN = 2 * MiB;
constexpr size_t WS_WUQ = 6 * MiB;
constexpr size_t WS_WUKV = 7 * MiB;
constexpr size_t WS_WOUT = 8 * MiB;
constexpr size_t WS_WR = 10 * MiB;
constexpr size_t WS_WGU = 11 * MiB;
constexpr size_t WS_WD = 43 * MiB;
constexpr size_t WS_TAB = 60 * MiB;
constexpr size_t WS_SSQQ = 68 * MiB;
constexpr size_t WS_SSQKV = 69 * MiB;
constexpr size_t WS_OSS = 70 * MiB;
constexpr size_t WS_SSQ2 = 74 * MiB;
constexpr size_t WS_RSTD2 = 78 * MiB;
constexpr size_t WS_EIDX = 79 * MiB;
constexpr size_t WS_EW = 80 * MiB;
constexpr size_t WS_RANK = 81 * MiB;
constexpr size_t WS_CNT = 82 * MiB;
constexpr size_t WS_TILEE = 82 * MiB + 65536;
constexpr size_t WS_SLOTTOK = 83 * MiB;
constexpr size_t WS_SLOTW = 84 * MiB;
constexpr size_t WS_LOGITS = 85 * MiB;
constexpr size_t WS_KROPE = 101 * MiB;
constexpr size_t WS_H = 106 * MiB;
constexpr size_t WS_QM = 106 * MiB;
constexpr size_t WS_X1B = 106 * MiB;
constexpr size_t WS_QS = 234 * MiB, WS_KS = 298 * MiB, WS_VS = 362 * MiB;
constexpr size_t WS_CQ = 426 * MiB;
constexpr size_t WS_CKV = 458 * MiB;
constexpr size_t WS_X1 = 234 * MiB;
constexpr size_t WS_KVM = 490 * MiB;
constexpr size_t WS_HID = 490 * MiB;
constexpr size_t WS_O = 618 * MiB;
constexpr size_t WS_YB = 618 * MiB;
constexpr size_t WS_END = 874 * MiB;
constexpr int CW_BAR = 4096;

constexpr int RING_OFF = 0, RING_BYTES = 131072;
constexpr int LDSCTL_OFF = RING_BYTES, MISC_OFF = LDSCTL_OFF + 320;
constexpr int LDS_BYTES = 147456;

#define GAS __attribute__((address_space(1)))
#define LAS __attribute__((address_space(3)))
typedef unsigned short bf16;
typedef unsigned v4u __attribute__((ext_vector_type(4)));
typedef float f32x4 __attribute__((ext_vector_type(4)));
typedef short bf16x8 __attribute__((ext_vector_type(8)));
typedef GAS unsigned gu32;
typedef GAS unsigned long long gu64;
#define RLX_AGENT __ATOMIC_RELAXED, __HIP_MEMORY_SCOPE_AGENT
#define LDS_WAIT() asm volatile("s_waitcnt lgkmcnt(0)" ::: "memory")
#define VM_WAIT() asm volatile("s_waitcnt vmcnt(0)" ::: "memory")
__device__ __forceinline__ unsigned long long rt() { return __builtin_amdgcn_s_memrealtime(); }
__device__ __forceinline__ unsigned f2bf(float f) { unsigned u = __builtin_bit_cast(unsigned, f); return (u + 0x7fffu + ((u >> 16) & 1u)) >> 16; }
__device__ __forceinline__ unsigned pk2(float lo, float hi) { return f2bf(lo) | (f2bf(hi) << 16); }

#define XB_TMO      128
#define XB_XCNT(j)  (256  + 64 * (j))
#define XB_XSUB(j)  (1280 + 64 * (j))
#define XB_XGEN(j)  (2304 + 64 * (j))
#define XB_TOP      3328
#define XB_TOPGEN   3392
#define XCD_BAR_WORDS 3456
#define XB_SPIN_CAP (1u << 18)

__device__ __forceinline__ unsigned xb_ld(unsigned* p)              { return __hip_atomic_load(p, __ATOMIC_RELAXED, __HIP_MEMORY_SCOPE_AGENT); }
__device__ __forceinline__ unsigned xb_add(unsigned* p, unsigned v) { return __hip_atomic_fetch_add(p, v, __ATOMIC_RELAXED, __HIP_MEMORY_SCOPE_AGENT); }
__device__ __forceinline__ unsigned xb_xcc_id() { return (unsigned)__builtin_amdgcn_s_getreg((3 << 11) | 20) & 0xFu; }
#define XB_SPIN(cond, bar) do { unsigned _sp = 0; while (cond) { __builtin_amdgcn_s_sleep(1); \
    if ((++_sp & 255u) == 0u) { if (xb_ld(&(bar)[XB_TMO])) break; if (_sp > XB_SPIN_CAP) { atomicAdd(&(bar)[XB_TMO], 1u); break; } } } } while (0)

struct XcdBarrier {
    unsigned* bar; unsigned x;
    volatile LAS unsigned* st;
};

__device__ __forceinline__ XcdBarrier xcd_barrier_post(unsigned* bar, volatile LAS unsigned* st) {
    XcdBarrier b; b.bar = bar; b.x = xb_xcc_id(); b.st = st;
    if (threadIdx.x == 0) (void)xb_add(&bar[XB_XCNT(b.x)], 1u);
    return b;
}
__device__ __forceinline__ void xcd_barrier_complete(unsigned* bar, unsigned x, unsigned& nloc, unsigned& nx) {
    const unsigned G = gridDim.x * gridDim.y * gridDim.z;
    unsigned sum, cnt, mine, sp = 0u;
    for (;;) {
        sum = 0u; cnt = 0u; mine = 0u;
#pragma unroll
        for (unsigned j = 0; j < 16; ++j) { const unsigned c = xb_ld(&bar[XB_XCNT(j)]); sum += c; cnt += (c > 0u) ? 1u : 0u; mine = (j == x) ? c : mine; }
        if (sum == G) break;
        __builtin_amdgcn_s_sleep(1);
        if ((++sp & 255u) == 0u) { if (xb_ld(&bar[XB_TMO])) break; if (sp > XB_SPIN_CAP) { atomicAdd(&bar[XB_TMO], 1u); break; } }
    }
    nloc = mine > 0u ? mine : 1u; nx = cnt > 0u ? cnt : 1u;
}

__device__ __forceinline__ void xcd_barrier(const XcdBarrier& b) {
    asm volatile("s_waitcnt vmcnt(0)" ::: "memory");
    __syncthreads();
    if (threadIdx.x == 0) {
        unsigned* bar = b.bar;
        __builtin_amdgcn_s_waitcnt(0);
        unsigned nloc = b.st[0], nx = b.st[1];
        if (nloc == 0u) { xcd_barrier_complete(bar, b.x, nloc, nx); b.st[0] = nloc; b.st[1] = nx; }
        const unsigned old = xb_add(&bar[XB_XSUB(b.x)], 1u);
        const unsigned gen = old / nloc;
        if (old + 1u == (gen + 1u) * nloc) {
            __builtin_amdgcn_fence(__ATOMIC_RELEASE, "agent");
            asm volatile("s_waitcnt vmcnt(0)" ::: "memory");
            const unsigned og = xb_add(&bar[XB_TOP], 1u);
            const unsigned tg = og / nx;
            if (og + 1u == (tg + 1u) * nx) xb_add(&bar[XB_TOPGEN], 1u);
            else XB_SPIN(xb_ld(&bar[XB_TOPGEN]) == tg, bar);
            __builtin_amdgcn_fence(__ATOMIC_ACQUIRE, "agent");
            xb_add(&bar[XB_XGEN(b.x)], 1u);
            asm volatile("s_waitcnt vmcnt(0)" ::: "memory");
        } else {
            XB_SPIN(xb_ld(&bar[XB_XGEN(b.x)]) == gen, bar);
            __builtin_amdgcn_fence(__ATOMIC_ACQUIRE, "agent");
            asm volatile("s_waitcnt vmcnt(0)" ::: "memory");
        }
    }
    __syncthreads();
}

typedef float f32x2v __attribute__((ext_vector_type(2)));
typedef unsigned u32x2v __attribute__((ext_vector_type(2)));
namespace epi {
using pg8::f32x4; using pg8::u32x4; using pg8::Unit; using pg8::bf16_t; using pg8::cvt_pk_bf16;
typedef float f32x2 __attribute__((ext_vector_type(2)));
typedef unsigned u32x2 __attribute__((ext_vector_type(2)));
__device__ __forceinline__ u32x4 pack8(const f32x4 a, const f32x4 b) { u32x4 w; w.x = cvt_pk_bf16(a[0], a[1]); w.y = cvt_pk_bf16(a[2], a[3]); w.z = cvt_pk_bf16(b[0], b[1]); w.w = cvt_pk_bf16(b[2], b[3]); return w; }
__device__ __forceinline__ float sq8(const f32x4 a, const f32x4 b) { return (a[0] * a[0] + a[1] * a[1]) + (a[2] * a[2] + a[3] * a[3]) + (b[0] * b[0] + b[1] * b[1]) + (b[2] * b[2] + b[3] * b[3]); }
__device__ __forceinline__ void rope8(f32x4& a, f32x4& b, const float* tab  ) {
    const f32x4 t0 = *(const f32x4*)tab, t1 = *(const f32x4*)(tab + 4);
    f32x4 ra, rb;
    ra[0] = a[0] * t0[0] - a[1] * t0[1]; ra[1] = a[1] * t0[0] + a[0] * t0[1];
    ra[2] = a[2] * t0[2] - a[3] * t0[3]; ra[3] = a[3] * t0[2] + a[2] * t0[3];
    rb[0] = b[0] * t1[0] - b[1] * t1[1]; rb[1] = b[1] * t1[0] + b[0] * t1[1];
    rb[2] = b[2] * t1[2] - b[3] * t1[3]; rb[3] = b[3] * t1[2] + b[2] * t1[3];
    a = ra; b = rb;
}

struct EpiProj {
    static constexpr bool PERM = true;
    bf16_t *QKV, *CQ, *CKV, *KROPE; float *SSQQ, *SSQKV; const float* TAB;
    __device__ __forceinline__ void operator()(const f32x4 (&acc)[2][2][4][2], const Unit& u, int wr, int wc, int fr, int fq) const {
        const int pn = u.pn; int rowv = u.pm * 256 + wr * 64 + fr;
        if (pn < 6) {
            bf16_t* dst = QKV + (size_t)(pn >> 1) * ((size_t)T * 512) + (pn & 1) * 256 + wc * 32 + 8 * fq; const float sc = (pn < 2) ? SB_C2 : 1.0f;
#pragma unroll
            for (int ai = 0; ai < 2; ++ai)
#pragma unroll
                for (int m = 0; m < 4; ++m) { asm volatile("" : "+v"(rowv)); const int row = rowv; rowv += (m == 3) ? 80 : 16;
#pragma unroll
                    for (int bj = 0; bj < 2; ++bj) *(u32x4*)(dst + (size_t)row * 512 + bj * 128) = pack8(acc[ai][bj][m][0] * sc, acc[ai][bj][m][1] * sc); }
        } else if (pn == 6) {
#pragma unroll
            for (int ai = 0; ai < 2; ++ai)
#pragma unroll
                for (int m = 0; m < 4; ++m) { asm volatile("" : "+v"(rowv)); const int row = rowv; rowv += (m == 3) ? 80 : 16; float s = 0.f;
#pragma unroll
                    for (int bj = 0; bj < 2; ++bj) { const int c = bj * 128 + wc * 32 + 8 * fq;
                        *(u32x4*)(CQ + (size_t)row * 256 + c) = pack8(acc[ai][bj][m][0], acc[ai][bj][m][1]); s += sq8(acc[ai][bj][m][0], acc[ai][bj][m][1]); }
                    s += __shfl_xor(s, 16); s += __shfl_xor(s, 32);
                    if (fq == 0) SSQQ[(size_t)row * 4 + wc] = s; }
        } else {
#pragma unroll
            for (int ai = 0; ai < 2; ++ai)
#pragma unroll
                for (int m = 0; m < 4; ++m) { asm volatile("" : "+v"(rowv)); const int row = rowv; rowv += (m == 3) ? 80 : 16;
                    { const int c = wc * 32 + 8 * fq;
                      *(u32x4*)(CKV + (size_t)row * 256 + c) = pack8(acc[ai][0][m][0], acc[ai][0][m][1]);
                      *(u32x4*)(CKV + (size_t)row * 256 + 128 + c) = (u32x4){0u, 0u, 0u, 0u};
                      float s = sq8(acc[ai][0][m][0], acc[ai][0][m][1]); s += __shfl_xor(s, 16); s += __shfl_xor(s, 32);
                      if (fq == 0) SSQKV[(size_t)row * 4 + wc] = s; }
                    if (wc == 0) {
                        f32x4 a = acc[ai][1][m][0], b = acc[ai][1][m][1];
                        rope8(a, b, TAB + (size_t)row * 32 + 8 * fq);
                        *(u32x4*)(KROPE + (size_t)row * 32 + 8 * fq) = pack8(a, b);
                    }
                    if (m & 1) asm volatile("" ::: "memory"); }
        }
    }
};

struct EpiQup {
    static constexpr bool PERM = true;
    bf16_t* QM; const float* SSQQ; const float* TAB;
    __device__ __forceinline__ void operator()(const f32x4 (&acc)[2][2][4][2], const Unit& u, int wr, int wc, int fr, int fq) const {
        int rowv = u.pm * 256 + wr * 64 + fr;
#pragma unroll
        for (int ai = 0; ai < 2; ++ai)
#pragma unroll
            for (int m = 0; m < 4; ++m) {
                asm volatile("" : "+v"(rowv)); const int row = rowv; rowv += (m == 3) ? 80 : 16;
                const f32x4 ss = *(const f32x4*)(SSQQ + (size_t)row * 4);
                const float rs = rsqrtf(((ss[0] + ss[1]) + (ss[2] + ss[3])) * (1.0f / QLORA) + EPS) * MLA_C2;
#pragma unroll
                for (int bj = 0; bj < 2; ++bj) { const int c = u.pn * 256 + bj * 128 + wc * 32 + 8 * fq; const int j = c % QKD;
                    f32x4 a = acc[ai][bj][m][0] * rs, b = acc[ai][bj][m][1] * rs;
                    if (j >= NOPE) rope8(a, b, TAB + (size_t)row * 32 + (j - NOPE));
                    *(u32x4*)(QM + (size_t)row * 768 + c) = pack8(a, b); }
                if (m & 1) asm volatile("" ::: "memory");
            }
    }
};
struct EpiKVup {
    static constexpr bool PERM = true;
    bf16_t* KVM; const float* SSQKV;
    __device__ __forceinline__ void operator()(const f32x4 (&acc)[2][2][4][2], const Unit& u, int wr, int wc, int fr, int fq) const {
        int rowv = u.pm * 256 + wr * 64 + fr;
#pragma unroll
        for (int ai = 0; ai < 2; ++ai)
#pragma unroll
            for (int m = 0; m < 4; ++m) {
                asm volatile("" : "+v"(rowv)); const int row = rowv; rowv += (m == 3) ? 80 : 16;
                const f32x4 ss = *(const f32x4*)(SSQKV + (size_t)row * 4);
                const float rs = rsqrtf(((ss[0] + ss[1]) + (ss[2] + ss[3])) * (1.0f / KVLORA) + EPS);
#pragma unroll
                for (int bj = 0; bj < 2; ++bj) { const int c = u.pn * 256 + bj * 128 + wc * 32 + 8 * fq;
                    *(u32x4*)(KVM + (size_t)row * 1024 + c) = pack8(acc[ai][bj][m][0] * rs, acc[ai][bj][m][1] * rs); }
                if (m & 1) asm volatile("" ::: "memory");
            }
    }
};
struct EpiX1 {
    static constexpr bool PERM = true;
    const float* X; float* X1; bf16_t* X1B; float* SSQ2;
    __device__ __forceinline__ void operator()(const f32x4 (&acc)[2][2][4][2], const Unit& u, int wr, int wc, int fr, int fq) const {
        int rowv = u.pm * 256 + wr * 64 + fr;
#pragma unroll
        for (int ai = 0; ai < 2; ++ai)
#pragma unroll
            for (int m = 0; m < 4; ++m) {
                asm volatile("" : "+v"(rowv)); const int row = rowv; rowv += (m == 3) ? 80 : 16; float s = 0.f;
#pragma unroll
                for (int bj = 0; bj < 2; ++bj) { const size_t off = (size_t)row * 1024 + u.pn * 256 + bj * 128 + wc * 32 + 8 * fq;
                    const f32x4 a = acc[ai][bj][m][0] + *(const f32x4*)(X + off), b = acc[ai][bj][m][1] + *(const f32x4*)(X + off + 4);
                    *(f32x4*)(X1 + off) = a; *(f32x4*)(X1 + off + 4) = b; *(u32x4*)(X1B + off) = pack8(a, b); s += sq8(a, b); }
                s += __shfl_xor(s, 16); s += __shfl_xor(s, 32);
                if (fq == 0) SSQ2[(size_t)row * 16 + u.pn * 4 + wc] = s;
                if (m & 1) asm volatile("" ::: "memory");
            }
    }
};
struct EpiRouter {
    static constexpr bool PERM = true;
    const float* SSQ2; float* LOGITS; float* RSTD2;
    __device__ __forceinline__ void operator()(const f32x4 (&acc)[2][2][4][2], const Unit& u, int wr, int wc, int fr, int fq) const {
        int rowv = u.pm * 256 + wr * 64 + fr;
        if (wc >= 2) return;
#pragma unroll
        for (int ai = 0; ai < 2; ++ai)
#pragma unroll
            for (int m = 0; m < 4; ++m) {
                asm volatile("" : "+v"(rowv)); const int row = rowv; rowv += (m == 3) ? 80 : 16;
                const f32x4 s0 = *(const f32x4*)(SSQ2 + (size_t)row * 16), s1 = *(const f32x4*)(SSQ2 + (size_t)row * 16 + 4), s2 = *(const f32x4*)(SSQ2 + (size_t)row * 16 + 8), s3 = *(const f32x4*)(SSQ2 + (size_t)row * 16 + 12);
                const float tot = (((s0[0] + s0[1]) + (s0[2] + s0[3])) + ((s1[0] + s1[1]) + (s1[2] + s1[3]))) + (((s2[0] + s2[1]) + (s2[2] + s2[3])) + ((s3[0] + s3[1]) + (s3[2] + s3[3])));
                const float rs = rsqrtf(tot * (1.0f / DM) + EPS);
                const int c = wc * 32 + 8 * fq;
                *(f32x4*)(LOGITS + (size_t)row * 64 + c) = acc[ai][0][m][0] * rs; *(f32x4*)(LOGITS + (size_t)row * 64 + c + 4) = acc[ai][0][m][1] * rs;
                if (wc == 0 && fq == 0) RSTD2[row] = rs;
                if (m & 1) asm volatile("" ::: "memory");
            }
    }
};
struct EpiGateUp {
    static constexpr bool PERM = true;
    const int* SLOTTOK; const float* RSTD2; bf16_t* HID;
    __device__ __forceinline__ void operator()(const f32x4 (&acc)[2][2][4][2], const Unit& u, int wr, int wc, int fr, int fq) const {
        int rowv = u.pm * 256 + wr * 64 + fr;
        const int pnl = u.pn & 1;
#pragma unroll
        for (int ai = 0; ai < 2; ++ai)
#pragma unroll
            for (int m = 0; m < 4; ++m) {
                asm volatile("" : "+v"(rowv)); const int slot = rowv; rowv += (m == 3) ? 80 : 16;
                const int st = SLOTTOK[slot]; const float rs = st < 0 ? 0.f : RSTD2[st >> 1];
#pragma unroll
                for (int bj = 0; bj < 2; ++bj) { const int hc = pnl * 128 + bj * 64 + wc * 16 + 4 * fq;
                    const f32x4 gt = acc[ai][bj][m][0] * rs, up = acc[ai][bj][m][1] * rs; f32x4 h;
#pragma unroll
                    for (int i = 0; i < 4; ++i) h[i] = gt[i] * up[i] * __builtin_amdgcn_rcpf(1.0f + __builtin_amdgcn_exp2f(-gt[i] * LOG2E));
                    u32x2 w; w.x = cvt_pk_bf16(h[0], h[1]); w.y = cvt_pk_bf16(h[2], h[3]);
                    *(u32x2*)(HID + (size_t)slot * 256 + hc) = w; }
                if (m & 1) asm volatile("" ::: "memory");
            }
    }
};
struct EpiDown {
    static constexpr bool PERM = true;
    const int* SLOTTOK; const float* SLOTW; bf16_t* YB;
    __device__ __forceinline__ void operator()(const f32x4 (&acc)[2][2][4][2], const Unit& u, int wr, int wc, int fr, int fq) const {
        int rowv = u.pm * 256 + wr * 64 + fr;
        const int pnl = u.pn & 3;
#pragma unroll
        for (int ai = 0; ai < 2; ++ai)
#pragma unroll
            for (int m = 0; m < 4; ++m) {
                asm volatile("" : "+v"(rowv)); const int slot = rowv; rowv += (m == 3) ? 80 : 16;
                const int st = SLOTTOK[slot]; const float w = SLOTW[slot];
                if (st >= 0) {
#pragma unroll
                    for (int bj = 0; bj < 2; ++bj) { const int c = pnl * 256 + bj * 128 + wc * 32 + 8 * fq;
                        *(u32x4*)(YB + (size_t)st * 1024 + c) = pack8(acc[ai][bj][m][0] * w, acc[ai][bj][m][1] * w); }
                }
                if (m & 1) asm volatile("" ::: "memory");
            }
    }
};
struct MoeOrder {
    const int* tile_e; int ntiles, npn, G, c;
    __device__ __forceinline__ bool next(int i, Unit& u) const {
        const int L = i * G + c; if (L >= ntiles * npn) return false;
        const int tile = L / npn, pn = L - tile * npn; u.pm = tile; u.pn = tile_e[tile] * npn + pn; return true;
    }
    __device__ __forceinline__ void a_ready(const Unit&) const {}
    __device__ __forceinline__ void done(const Unit&) const {}
};
}

#ifndef SB_EARLY_EXIT
#define SB_EARLY_EXIT 0
#endif
namespace att {
typedef __attribute__((address_space(3))) unsigned char l8;
typedef short bf16x8 __attribute__((ext_vector_type(8)));
typedef short s16x4 __attribute__((ext_vector_type(4)));
typedef float f32x16 __attribute__((ext_vector_type(16)));
typedef float f32x4 __attribute__((ext_vector_type(4)));
typedef unsigned u32x4 __attribute__((ext_vector_type(4)));
typedef unsigned short bf16_t;
constexpr int SLOT_K = 12288, SLOT_V = 8192;
constexpr int L_K = 0, L_V = 2 * SLOT_K, L_WS = L_V + 2 * SLOT_V, L_FLAG = L_WS + 8 * 256, L_OST = L_FLAG + 256, L_END = L_OST + 8 * 4096;
__device__ __forceinline__ int crow(int r, int hi) { return (r & 3) + 8 * (r >> 2) + 4 * hi; }
__device__ __forceinline__ void glds16(const void* gsrc, unsigned lds_dst) { unsigned keep;
    asm volatile("s_mov_b32 %0, m0\n\ts_mov_b32 m0, %2\n\ts_nop 0\n\tglobal_load_lds_dwordx4 %1, off\n\ts_mov_b32 m0, %0" : "=&s"(keep) : "v"(gsrc), "s"(lds_dst) : "memory"); }
__device__ __forceinline__ unsigned cvtpk(float lo, float hi) { return pg8::cvt_pk_bf16(lo, hi); }
__device__ __forceinline__ s16x4 vtr(const l8* p) { typedef short v4i16_t __attribute__((ext_vector_type(4)));
    return __builtin_bit_cast(s16x4, __builtin_amdgcn_ds_read_tr16_b64_v4i16((__attribute__((address_space(3))) v4i16_t*)p)); }
__device__ __forceinline__ float bf2f(unsigned short b) { return __builtin_bit_cast(float, (unsigned)b << 16); }
#define ATT_WAIT_BAR() asm volatile("s_waitcnt vmcnt(0) lgkmcnt(0)\n\ts_barrier" ::: "memory")

struct Tensors { const bf16_t* Q; int qp, qh;
                 const bf16_t* K; int kp, kh;
                 const bf16_t* KR;
                 const bf16_t* V; int vp, vh;
                 bf16_t* O; int ocol;
                 float* OSS; int ossc; };

template <int MODE>
__device__ __forceinline__ void attn_unit(l8* shm, int bh, int qb, const Tensors& P) {
    constexpr int NC2 = MODE ? 6 : 4;
    const int tid = threadIdx.x, lane = tid & 63, r32 = lane & 31, hi = lane >> 5; const int wid = __builtin_amdgcn_readfirstlane(tid >> 6);
    const int b = bh >> 3, h = bh & 7; const long rowbase = (long)b * SEQ; const int q0 = qb * 256, a = q0 + 32 * wid;
    const unsigned lds0 = (unsigned)(uintptr_t)shm;
    __attribute__((address_space(3))) float* wsf = (__attribute__((address_space(3))) float*)(shm + L_WS) + wid * 64;
    __attribute__((address_space(3))) unsigned* flg = (__attribute__((address_space(3))) unsigned*)(shm + L_FLAG);
    const int NT = (q0 + 256) / 64;
    const bf16_t* ksrc = P.K + (rowbase + lane) * P.kp + h * P.kh + wid * 8;
    const bf16_t* krsrc = MODE ? P.KR + (rowbase + lane) * ROPE + (wid & 3) * 8 : nullptr;
    const bf16_t* vsrc = P.V + (rowbase + 16 * (wid & 3) + (lane >> 2)) * P.vp + h * P.vh + (wid >> 2) * 32 + (lane & 3) * 8;
#define ATT_DMA(j, s) do { const unsigned kd_ = (unsigned)__builtin_amdgcn_readfirstlane(lds0 + L_K + (s) * SLOT_K + wid * 1024); \
        glds16(ksrc + (long)(j) * 64 * P.kp, kd_); \
        if (MODE && wid < 4) glds16(krsrc + (long)(j) * 64 * ROPE, (unsigned)__builtin_amdgcn_readfirstlane(lds0 + L_K + (s) * SLOT_K + (8 + wid) * 1024)); \
        glds16(vsrc + (long)(j) * 64 * P.vp, (unsigned)__builtin_amdgcn_readfirstlane(lds0 + L_V + (s) * SLOT_V + wid * 1024)); } while (0)
    ATT_DMA(NT - 1, 0);
    if (lane < 2) flg[lane * 8 + wid] = 0u;
    bf16x8 qr[NC2];
    { const bf16_t* qw = P.Q + (rowbase + a + r32) * P.qp + h * P.qh + hi * 8;
#pragma unroll
      for (int c2 = 0; c2 < NC2; ++c2) qr[c2] = *(const bf16x8*)(qw + c2 * 16); }
    f32x16 o0 = {}, o1 = {};
    float m_run = -1e30f, l_run = 0.f, R = 1.0f; bool done = false;
    const int vb = ((lane >> 4) & 1) * 32 + (lane & 3) * 8 + (4 * hi + ((lane & 15) >> 2)) * 64;
    for (int it = 0; it < NT; ++it) {
        const int j = NT - 1 - it, s = it & 1;
        ATT_WAIT_BAR();
        if (MODE == 0 && SB_EARLY_EXIT && it > 0) {
            const __attribute__((address_space(3))) unsigned* f = flg + ((it - 1) & 1) * 8;
            unsigned all = f[0] & f[1] & f[2] & f[3] & f[4] & f[5] & f[6] & f[7];
            if (__builtin_amdgcn_readfirstlane(all) != 0u) break;
        }
        if (it + 1 < NT) ATT_DMA(j - 1, s ^ 1);
        if (64 * j <= a && !done) {
            const l8* ks = shm + L_K + s * SLOT_K + hi * 1024 + r32 * 16;
            f32x16 p0 = {}, p1 = {};
#pragma unroll
            for (int c2 = 0; c2 < NC2; ++c2) {
                const bf16x8 k0 = *(const __attribute__((address_space(3))) bf16x8*)(ks + c2 * 2048), k1 = *(const __attribute__((address_space(3))) bf16x8*)(ks + c2 * 2048 + 512);
                p0 = __builtin_amdgcn_mfma_f32_32x32x16_bf16(k0, qr[c2], p0, 0, 0, 0);
                p1 = __builtin_amdgcn_mfma_f32_32x32x16_bf16(k1, qr[c2], p1, 0, 0, 0);
            }
            if (64 * j + 63 >= a) {
                const int tq = a + r32 - 64 * j - (MODE ? 0 : 1);
#pragma unroll
                for (int r = 0; r < 16; ++r) { const int kk = crow(r, hi); if (kk > tq) p0[r] = -INFINITY; if (kk + 32 > tq) p1[r] = -INFINITY; }
            }
            unsigned pw[16];
            if (MODE == 1) {
                float rm = fmaxf(p0[0], p1[0]);
#pragma unroll
                for (int r = 1; r < 16; ++r) rm = fmaxf(rm, fmaxf(p0[r], p1[r]));
                { auto rr = __builtin_amdgcn_permlane32_swap(__float_as_uint(rm), __float_as_uint(rm), false, false); rm = fmaxf(__uint_as_float(rr[0]), __uint_as_float(rr[1])); }
                const float mn = fmaxf(m_run, rm), alpha = __builtin_amdgcn_exp2f(m_run - mn); m_run = mn;
                float ls = 0.f;
#pragma unroll
                for (int r = 0; r < 16; ++r) { p0[r] = __builtin_amdgcn_exp2f(p0[r] - mn); p1[r] = __builtin_amdgcn_exp2f(p1[r] - mn); ls += p0[r] + p1[r]; }
                l_run = l_run * alpha + ls;
                if (hi == 0) wsf[r32] = alpha;
#pragma unroll
                for (int g = 0; g < 4; ++g) { const f32x4 al = *(const __attribute__((address_space(3))) f32x4*)(wsf + 8 * g + 4 * hi);
#pragma unroll
                    for (int i = 0; i < 4; ++i) { o0[4 * g + i] *= al[i]; o1[4 * g + i] *= al[i]; } }
#pragma unroll
                for (int r = 0; r < 8; ++r) { pw[r] = cvtpk(p0[2 * r], p0[2 * r + 1]); pw[8 + r] = cvtpk(p1[2 * r], p1[2 * r + 1]); }
            } else {
                float bt0[16], bt1[16];
#pragma unroll
                for (int r = 0; r < 16; ++r) {
                    const float e0 = __builtin_amdgcn_exp2f(fminf(p0[r], 100.f)), e1 = __builtin_amdgcn_exp2f(fminf(p1[r], 100.f));
                    const float i0 = __builtin_amdgcn_rcpf(1.0f + e0), i1 = __builtin_amdgcn_rcpf(1.0f + e1);
                    p0[r] = i0; p1[r] = i1; bt0[r] = e0 * i0; bt1[r] = e1 * i1;
                }
                float RE = R;
#pragma unroll
                for (int g = 7; g >= 0; --g) {
                    float r0, r1, r2, r3, b0, b1, b2, b3;
                    if (g >= 4) { r0 = p1[4 * (g - 4)]; r1 = p1[4 * (g - 4) + 1]; r2 = p1[4 * (g - 4) + 2]; r3 = p1[4 * (g - 4) + 3]; b0 = bt1[4 * (g - 4)]; b1 = bt1[4 * (g - 4) + 1]; b2 = bt1[4 * (g - 4) + 2]; b3 = bt1[4 * (g - 4) + 3]; }
                    else { r0 = p0[4 * g]; r1 = p0[4 * g + 1]; r2 = p0[4 * g + 2]; r3 = p0[4 * g + 3]; b0 = bt0[4 * g]; b1 = bt0[4 * g + 1]; b2 = bt0[4 * g + 2]; b3 = bt0[4 * g + 3]; }
                    const float w2 = r3, w1 = w2 * r2, w0 = w1 * r1, G = w0 * r0;
                    auto sw = __builtin_amdgcn_permlane32_swap(__float_as_uint(G), __float_as_uint(G), false, false);
                    const float g0 = __uint_as_float(sw[0]), g1 = __uint_as_float(sw[1]);
                    const float Mx = RE * (hi ? 1.0f : g1);
                    const float a3 = b3 * Mx, a2 = b2 * w2 * Mx, a1 = b1 * w1 * Mx, a0 = b0 * w0 * Mx;
                    pw[2 * g] = cvtpk(a0, a1); pw[2 * g + 1] = cvtpk(a2, a3);
                    RE *= g0 * g1;
                }
                R = RE;
                if (SB_EARLY_EXIT) done = __all(R < 7.9e-31f);
            }
            const l8* vs = shm + L_V + s * SLOT_V + vb;
#pragma unroll
            for (int ks2 = 0; ks2 < 4; ++ks2) {
                const bf16x8 pa = __builtin_bit_cast(bf16x8, (u32x4){pw[4 * ks2], pw[4 * ks2 + 1], pw[4 * ks2 + 2], pw[4 * ks2 + 3]});
                { const s16x4 lo = vtr(vs + ks2 * 1024), hh = vtr(vs + ks2 * 1024 + 512);
                  o0 = __builtin_amdgcn_mfma_f32_32x32x16_bf16(pa, (bf16x8){lo[0], lo[1], lo[2], lo[3], hh[0], hh[1], hh[2], hh[3]}, o0, 0, 0, 0); }
                { const s16x4 lo = vtr(vs + 4096 + ks2 * 1024), hh = vtr(vs + 4096 + ks2 * 1024 + 512);
                  o1 = __builtin_amdgcn_mfma_f32_32x32x16_bf16(pa, (bf16x8){lo[0], lo[1], lo[2], lo[3], hh[0], hh[1], hh[2], hh[3]}, o1, 0, 0, 0); }
            }
        }
        if (MODE == 0 && SB_EARLY_EXIT) { if (lane == 0) flg[s * 8 + wid] = done ? 1u : 0u; }
    }
    if (MODE == 1) {
        { auto rr = __builtin_amdgcn_permlane32_swap(__float_as_uint(l_run), __float_as_uint(l_run), false, false); l_run = __uint_as_float(rr[0]) + __uint_as_float(rr[1]); }
        if (hi == 0) wsf[32 + r32] = __builtin_amdgcn_rcpf(l_run);
#pragma unroll
        for (int g = 0; g < 4; ++g) { const f32x4 il = *(const __attribute__((address_space(3))) f32x4*)(wsf + 32 + 8 * g + 4 * hi);
#pragma unroll
            for (int i = 0; i < 4; ++i) { o0[4 * g + i] *= il[i]; o1[4 * g + i] *= il[i]; } }
    }
    { __attribute__((address_space(3))) bf16_t* stg = (__attribute__((address_space(3))) bf16_t*)(shm + L_OST) + wid * 2048;
#pragma unroll
      for (int r = 0; r < 16; ++r) { const int orow = crow(r, hi);
          stg[orow * 64 + r32] = (bf16_t)(cvtpk(o0[r], 0.f) & 0xffffu); stg[orow * 64 + 32 + r32] = (bf16_t)(cvtpk(o1[r], 0.f) & 0xffffu); }
      asm volatile("s_waitcnt lgkmcnt(0)" ::: "memory");
      bf16_t* ow = P.O + (rowbase + a) * 1024 + P.ocol + h * 64;
#pragma unroll
      for (int i = 0; i < 4; ++i) { const int row = i * 8 + (lane >> 3), ch = lane & 7;
          const u32x4 v = *(const __attribute__((address_space(3))) u32x4*)(stg + row * 64 + ch * 8);
          *(u32x4*)(ow + (long)row * 1024 + ch * 8) = v;
          float sq = 0.f;
#pragma unroll
          for (int e = 0; e < 4; ++e) { const float x0 = __builtin_bit_cast(float, v[e] << 16), x1 = __builtin_bit_cast(float, v[e] & 0xffff0000u); sq += x0 * x0 + x1 * x1; }
          sq += __shfl_xor(sq, 1); sq += __shfl_xor(sq, 2); sq += __shfl_xor(sq, 4);
          if (ch == 0) P.OSS[(rowbase + a + row) * 16 + P.ossc + h] = sq; } }
    ATT_WAIT_BAR();
#undef ATT_DMA
}
}

__device__ __forceinline__ float wave_sum(float v) {
#pragma unroll
    for (int o = 1; o < 64; o <<= 1) v += __shfl_xor(v, o);
    return v;
}
__device__ __forceinline__ float bflo(unsigned w) { return __builtin_bit_cast(float, w << 16); }
__device__ __forceinline__ float bfhi(unsigned w) { return __builtin_bit_cast(float, w & 0xffff0000u); }

template <class V> __device__ __forceinline__ void tr_item(const V& val, int K, int nblk, bf16* WT, LAS float* scr, int item, int lane) {
    const int kb = item / nblk, nb = item - kb * nblk, k0 = 64 * kb, n0 = 32 * nb;
#pragma unroll 8
    for (int i = 0; i < 32; ++i) { const int kk = 2 * i + (lane >> 5); scr[kk * 33 + (lane & 31)] = val(k0 + kk, n0 + (lane & 31)); }
    LDS_WAIT(); asm volatile("" ::: "memory");
    const int c = lane & 7;
#pragma unroll
    for (int j = 0; j < 4; ++j) { const int n = (lane >> 3) + 8 * j; const LAS float* s = scr + (8 * c) * 33 + n;
        v4u o; o.x = pk2(s[0 * 33], s[1 * 33]); o.y = pk2(s[2 * 33], s[3 * 33]); o.z = pk2(s[4 * 33], s[5 * 33]); o.w = pk2(s[6 * 33], s[7 * 33]);
        *(GAS v4u*)(WT + (size_t)(n0 + n) * K + k0 + 8 * c) = o; }
    LDS_WAIT(); asm volatile("" ::: "memory");
}
struct VWin { const float* w; __device__ __forceinline__ float operator()(int k, int n) const {
    if (n >= INC) return 0.f; const int i = n - 1920; const int src = (i < 0) ? n : 1920 + (i >> 1) + 16 * (i & 1); return w[(size_t)k * INC + src]; } };
struct VWuq { const float* w; const float* g; __device__ __forceinline__ float operator()(int k, int n) const {
    const int h = n / QKD, j = n - h * QKD, i = j - NOPE; const int src = (i < 0) ? n : h * QKD + NOPE + (i >> 1) + 16 * (i & 1); return w[(size_t)k * 768 + src] * g[k]; } };
struct VWukv { const float* w; const float* g; __device__ __forceinline__ float operator()(int k, int n) const { return k < KVLORA ? w[(size_t)k * 1024 + n] * g[k] : 0.f; } };
struct VWout { const float* w; const float* gs; const float* gm; __device__ __forceinline__ float operator()(int k, int n) const { return w[(size_t)k * 1024 + n] * (k < SBW ? gs[k] : gm[k - SBW]); } };
struct VWr { const float* wg; const float* we; const float* g; __device__ __forceinline__ float operator()(int k, int n) const {
    if (n < NGRP) return wg[(size_t)k * NGRP + n] * g[k]; if (n < NGRP + NEXP) return we[(size_t)k * NEXP + (n - NGRP)] * g[k]; return 0.f; } };
struct VWgu { const float* wgt; long long dlt  ; const float* g; __device__ __forceinline__ float operator()(int k, int n) const {
    const int hc = 4 * (n >> 3) + (n & 3); const float* w = (const float*)((uintptr_t)wgt + (uintptr_t)(((n >> 2) & 1) * dlt)); return w[(size_t)k * DEXP + hc] * g[k]; } };
struct VWd { const float* w; __device__ __forceinline__ float operator()(int k, int n) const { return w[(size_t)k * DM + n]; } };

struct Args { const void* in[20]; float* out; unsigned char* ws; int ph_lo, ph_hi, pad0, pad1; };
constexpr int NPHASE = 12;
__global__ void __launch_bounds__(NWAVES * 64, 2) fwd_kernel(Args args) {
    extern __shared__ __attribute__((aligned(16))) unsigned char lds_raw[];
    LAS unsigned char* lds = (LAS unsigned char*)lds_raw;
    volatile LAS unsigned* MISC = (volatile LAS unsigned*)(lds + MISC_OFF);
    const int tid = threadIdx.x, lane = tid & 63, wave = __builtin_amdgcn_readfirstlane(tid >> 6);
    const int G = gridDim.x, bx = blockIdx.x;
    const __attribute__((address_space(4))) Args* KA = (const __attribute__((address_space(4))) Args*)__builtin_amdgcn_kernarg_segment_ptr();
#define FIN(i) ((const float*)KA->in[i])
#define WSP(TY, off) ((TY*)(KA->ws + (off)))
    gu32* ctl = (gu32*)WSP(unsigned char, WS_CTL);
    for (int u = tid; u < (LDS_BYTES - LDSCTL_OFF) / 4; u += NWAVES * 64) ((LAS unsigned*)(lds + LDSCTL_OFF))[u] = 0u;
    __syncthreads();
    const int lo = KA->ph_lo, hi = KA->ph_hi;
    const bool use_bar = (hi - lo) > 1;
    XcdBarrier bar; bar.bar = (unsigned*)(ctl + CW_BAR); bar.x = 0; bar.st = nullptr;
    if (use_bar) bar = xcd_barrier_post((unsigned*)(ctl + CW_BAR), MISC + 8);
#ifndef PH_MASK
#define PH_MASK 0xfff
#endif
#define IN(k) ((((PH_MASK) >> (k)) & 1) && lo <= (k) && (k) < hi)
#define SEAM(k) do { if (IN(k) && IN((k) + 1)) xcd_barrier(bar); } while (0)
    const int gw = bx * NWAVES + wave, NGW = G * NWAVES;

#ifdef DBG_ZERO
    if (IN(0)) {
        v4u* z = (v4u*)(KA->ws + MiB);
        for (size_t i = (size_t)bx * (NWAVES * 64) + tid; i < (WS_END - MiB) / 16; i += (size_t)G * NWAVES * 64) z[i] = (v4u){0u, 0u, 0u, 0u};
        for (int u = tid; u < LDSCTL_OFF / 4; u += NWAVES * 64) ((LAS unsigned*)lds)[u] = 0u;
        __syncthreads();
        if (use_bar) xcd_barrier(bar);
    }
#endif
    if (IN(0)) {
        LAS float* scr = (LAS float*)(lds + RING_OFF + wave * 16384);
        constexpr int I_WIN = 16 * 64, I_WUQ = 4 * 24, I_WUKV = 4 * 32, I_WOUT = 16 * 32, I_WR = 16 * 8, I_GU1 = 16 * 16, I_GU = NEXP * I_GU1, I_D1 = 4 * 32, I_D = NEXP * I_D1;
        constexpr int NITEMS = I_WIN + I_WUQ + I_WUKV + I_WOUT + I_WR + I_GU + I_D;
        for (int it = gw; it < NITEMS; it += NGW) {
            int r = it;
            if (r < I_WIN) { tr_item(VWin{FIN(3)}, 1024, 64, WSP(bf16, WS_WIN), scr, r, lane); continue; } r -= I_WIN;
            if (r < I_WUQ) { tr_item(VWuq{FIN(5), FIN(4)}, 256, 24, WSP(bf16, WS_WUQ), scr, r, lane); continue; } r -= I_WUQ;
            if (r < I_WUKV) { tr_item(VWukv{FIN(7), FIN(6)}, 256, 32, WSP(bf16, WS_WUKV), scr, r, lane); continue; } r -= I_WUKV;
            if (r < I_WOUT) { tr_item(VWout{FIN(10), FIN(8), FIN(9)}, 1024, 32, WSP(bf16, WS_WOUT), scr, r, lane); continue; } r -= I_WOUT;
            if (r < I_WR) { tr_item(VWr{FIN(12), FIN(14), FIN(11)}, 1024, 8, WSP(bf16, WS_WR), scr, r, lane); continue; } r -= I_WR;
            if (r < I_GU) { const int e = r / I_GU1; const float* wg = FIN(16); const float* wu = FIN(17);
                tr_item(VWgu{wg + (size_t)e * DM * DEXP, (long long)((uintptr_t)wu - (uintptr_t)wg), FIN(11)}, 1024, 16, WSP(bf16, WS_WGU) + (size_t)e * 512 * 1024, scr, r - e * I_GU1, lane); continue; } r -= I_GU;
            { const int e = r / I_D1; tr_item(VWd{FIN(18) + (size_t)e * DEXP * DM}, 256, 32, WSP(bf16, WS_WD) + (size_t)e * 1024 * 256, scr, r - e * I_D1, lane); }
        }
        { const float* x = FIN(0); bf16* H = WSP(bf16, WS_H); f32x4 gn[4];
#pragma unroll
          for (int j = 0; j < 4; ++j) gn[j] = *((const GAS f32x4*)FIN(2) + lane + 64 * j);
          for (int m = gw; m < T; m += NGW) {
              const GAS f32x4* xr = (const GAS f32x4*)(x + (size_t)m * DM) + lane;
              f32x4 v[4]; float s2 = 0.f;
#pragma unroll
              for (int j = 0; j < 4; ++j) { v[j] = xr[64 * j]; s2 += (v[j].x * v[j].x + v[j].y * v[j].y) + (v[j].z * v[j].z + v[j].w * v[j].w); }
              const float rstd = rsqrtf(wave_sum(s2) * (1.f / DM) + EPS);
              GAS unsigned long long* o8 = (GAS unsigned long long*)(H + (size_t)m * DM) + lane;
#pragma unroll
              for (int j = 0; j < 4; ++j) { const f32x4 y = v[j] * rstd * gn[j]; o8[64 * j] = (unsigned long long)pk2(y.x, y.y) | ((unsigned long long)pk2(y.z, y.w) << 32); }
          } }
        { const int* positions = (const int*)KA->in[1]; float* TAB = WSP(float, WS_TAB);
          for (int idx = bx * (NWAVES * 64) + tid; idx < T * 16; idx += G * NWAVES * 64) {
            const int tok = idx >> 4, i = idx & 15;
            const double invd = ((i & 1) ? 0.56234132519034908039 : 1.0) * ((i & 2) ? 0.31622776601683793320 : 1.0) * ((i & 4) ? 0.1 : 1.0) * ((i & 8) ? 0.01 : 1.0);
            const double ang = (double)positions[tok] * invd;
            const double kq = rint(ang * 0.63661977236758134308);
            const double rr = fma(-kq, 1.57079632679489661923, ang) - kq * 6.123233995736766e-17;
            const float r = (float)rr, r2 = r * r;
            const float sn = r + r * r2 * (-1.6666667163e-01f + r2 * (8.3333337680e-03f + r2 * (-1.9841270114e-04f + r2 * 2.7557314297e-06f)));
            const float cs = 1.0f + r2 * (-0.5f + r2 * (4.1666667908e-02f + r2 * (-1.3888889225e-03f + r2 * (2.4801587642e-05f + r2 * -2.7557314297e-07f))));
            const int q = (int)((long long)kq & 3);
            const float c = (q == 0) ? cs : (q == 1) ? -sn : (q == 2) ? -cs : sn;
            const float s = (q == 0) ? sn : (q == 1) ? cs : (q == 2) ? -sn : -cs;
            *(GAS f32x2v*)(TAB + (size_t)idx * 2) = (f32x2v){c, s};
          } }
    }
    SEAM(0);
    if (IN(1)) {
        pg8::Gemm g{WSP(bf16, WS_H), WSP(bf16, WS_WIN), T, INP, DM, nullptr}; pg8::StaticOrder S; S.init(T, INP, G, bx);
        epi::EpiProj E{WSP(bf16, WS_QS), WSP(bf16, WS_CQ), WSP(bf16, WS_CKV), WSP(bf16, WS_KROPE), WSP(float, WS_SSQQ), WSP(float, WS_SSQKV), WSP(float, WS_TAB)};
        pg8::gemm_phase<epi::EpiProj, pg8::StaticOrder, true, false>(lds + RING_OFF, g, S, E);
    }
    SEAM(1);
    if (IN(2)) {
#ifndef P2SEL
#define P2SEL 3
#endif
        if (P2SEL & 1) { pg8::Gemm g{WSP(bf16, WS_CQ), WSP(bf16, WS_WUQ), T, 768, 256, nullptr}; pg8::StaticOrder S; S.init(T, 768, G, bx);
          epi::EpiQup E{WSP(bf16, WS_QM), WSP(float, WS_SSQQ), WSP(float, WS_TAB)};
          pg8::gemm_phase<epi::EpiQup, pg8::StaticOrder, true, false>(lds + RING_OFF, g, S, E); }
        if (P2SEL & 2) { pg8::Gemm g{WSP(bf16, WS_CKV), WSP(bf16, WS_WUKV), T, 1024, 256, nullptr}; pg8::StaticOrder S; S.init(T, 1024, G, bx);
          epi::EpiKVup E{WSP(bf16, WS_KVM), WSP(float, WS_SSQKV)};
          pg8::gemm_phase<epi::EpiKVup, pg8::StaticOrder, true, false>(lds + RING_OFF, g, S, E); }
    }
    SEAM(2);
    if (IN(3)) {
        bf16* OB = WSP(bf16, WS_O); float* OSS = WSP(float, WS_OSS); bf16* KVM = WSP(bf16, WS_KVM);
        const att::Tensors TS{WSP(bf16, WS_QS), 512, 64, WSP(bf16, WS_KS), 512, 64, nullptr, WSP(bf16, WS_VS), 512, 64, OB, 0, OSS, 0};
        const att::Tensors TM{WSP(bf16, WS_QM), 768, 96, KVM, 1024, 128, WSP(bf16, WS_KROPE), KVM + 64, 1024, 128, OB, 512, OSS, 8};
        for (int u = bx; u < BATCH * NH; u += G) {
            for (int qb = 7; qb >= 0; --qb) att::attn_unit<0>(lds + RING_OFF, u, qb, TS);
            for (int qb = 7; qb >= 0; --qb) att::attn_unit<1>(lds + RING_OFF, u, qb, TM);
        }
    }
    SEAM(3);
    if (IN(4)) {
        bf16* OB = WSP(bf16, WS_O); const float* OSS = WSP(float, WS_OSS);
        for (int m = gw; m < T; m += NGW) {
            const int grp = lane >> 5;
            const f32x4 s0 = *(const GAS f32x4*)(OSS + (size_t)m * 16 + grp * 8), s1 = *(const GAS f32x4*)(OSS + (size_t)m * 16 + grp * 8 + 4);
            const float rs = rsqrtf((((s0.x + s0.y) + (s0.z + s0.w)) + ((s1.x + s1.y) + (s1.z + s1.w))) * (1.f / 512.f) + EPS);
            GAS v4u* p = (GAS v4u*)(OB + (size_t)m * DM) + lane * 2;
#pragma unroll
            for (int j = 0; j < 2; ++j) { v4u w = p[j]; v4u o;
                o.x = pk2(bflo(w.x) * rs, bfhi(w.x) * rs); o.y = pk2(bflo(w.y) * rs, bfhi(w.y) * rs); o.z = pk2(bflo(w.z) * rs, bfhi(w.z) * rs); o.w = pk2(bflo(w.w) * rs, bfhi(w.w) * rs); p[j] = o; }
        }
    }
    SEAM(4);
    if (IN(5)) {
        pg8::Gemm g{WSP(bf16, WS_O), WSP(bf16, WS_WOUT), T, DM, DM, nullptr}; pg8::StaticOrder S; S.init(T, DM, G, bx);
        epi::EpiX1 E{FIN(0), WSP(float, WS_X1), WSP(bf16, WS_X1B), WSP(float, WS_SSQ2)};
        pg8::gemm_phase<epi::EpiX1, pg8::StaticOrder, true, false>(lds + RING_OFF, g, S, E);
    }
    SEAM(5);
    if (IN(6)) {
        pg8::Gemm g{WSP(bf16, WS_X1B), WSP(bf16, WS_WR), T, 256, DM, nullptr}; pg8::StaticOrder S; S.init(T, 256, G, bx);
        epi::EpiRouter E{WSP(float, WS_SSQ2), WSP(float, WS_LOGITS), WSP(float, WS_RSTD2)};
        pg8::gemm_phase<epi::EpiRouter, pg8::StaticOrder, true, false>(lds + RING_OFF, g, S, E);
    }
    SEAM(6);
    if (IN(7)) {
        LAS int* wcnt = (LAS int*)(lds + RING_OFF);
        const float* LOGITS = WSP(float, WS_LOGITS); const float* b_gr = FIN(13); const float* b_er = FIN(15);
        int* EIDX = WSP(int, WS_EIDX); float* EW = WSP(float, WS_EW); int* RANK = WSP(int, WS_RANK); int* CNT = WSP(int, WS_CNT);
        for (int ch = bx; ch < T / 256; ch += G) {
            const int tok = ch * 256 + tid; int e0 = -1, e1 = -1; float w0 = 0.f, w1 = 0.f;
            if (tid < 256) {
                const GAS f32x4* lp = (const GAS f32x4*)(LOGITS + (size_t)tok * 64);
                const f32x4 lg4 = lp[0];
                const float l0 = lg4.x + b_gr[0], l1 = lg4.y + b_gr[1], l2 = lg4.z + b_gr[2], l3 = lg4.w + b_gr[3];
                int gi = 0; float gm = l0;
                if (l1 > gm) { gm = l1; gi = 1; } if (l2 > gm) { gm = l2; gi = 2; } if (l3 > gm) { gm = l3; gi = 3; }
                const float gs = (expf(l0 - gm) + expf(l1 - gm)) + (expf(l2 - gm) + expf(l3 - gm));
                const float gval = 1.0f / gs;
                const f32x4 ea = lp[1 + 2 * gi], eb = lp[2 + 2 * gi];
                const GAS f32x4* bp = (const GAS f32x4*)(b_er + 8 * gi);
                const f32x4 ba = bp[0], bb = bp[1];
                const float el0 = ea.x + ba.x, el1 = ea.y + ba.y, el2 = ea.z + ba.z, el3 = ea.w + ba.w, el4 = eb.x + bb.x, el5 = eb.y + bb.y, el6 = eb.z + bb.z, el7 = eb.w + bb.w;
                int i1 = 0; float m1 = el0;
                if (el1 > m1) { m1 = el1; i1 = 1; } if (el2 > m1) { m1 = el2; i1 = 2; } if (el3 > m1) { m1 = el3; i1 = 3; } if (el4 > m1) { m1 = el4; i1 = 4; }
                if (el5 > m1) { m1 = el5; i1 = 5; } if (el6 > m1) { m1 = el6; i1 = 6; } if (el7 > m1) { m1 = el7; i1 = 7; }
                int i2 = -1; float m2 = -INFINITY;
                if (i1 != 0 && el0 > m2) { m2 = el0; i2 = 0; } if (i1 != 1 && el1 > m2) { m2 = el1; i2 = 1; } if (i1 != 2 && el2 > m2) { m2 = el2; i2 = 2; } if (i1 != 3 && el3 > m2) { m2 = el3; i2 = 3; }
                if (i1 != 4 && el4 > m2) { m2 = el4; i2 = 4; } if (i1 != 5 && el5 > m2) { m2 = el5; i2 = 5; } if (i1 != 6 && el6 > m2) { m2 = el6; i2 = 6; } if (i1 != 7 && el7 > m2) { m2 = el7; i2 = 7; }
                const float r = expf(m2 - m1);
                w0 = gval / (1.0f + r); w1 = gval * r / (1.0f + r);
                e0 = gi * EPG + i1; e1 = gi * EPG + i2;
            }
            int rk0 = 0, rk1 = 0;
            const unsigned long long ltm = (1ull << lane) - 1ull;
            for (int e = 0; e < NEXP; ++e) {
                const unsigned long long k0 = __ballot(e0 == e), k1 = __ballot(e1 == e);
                if (e0 == e) rk0 = __popcll(k0 & ltm);
                if (e1 == e) rk1 = __popcll(k1 & ltm);
                if (lane == 0 && wave < 4) { wcnt[(wave * 2 + 0) * 32 + e] = __popcll(k0); wcnt[(wave * 2 + 1) * 32 + e] = __popcll(k1); }
            }
            __syncthreads();
            if (tid < 256) {
                int b0 = 0, b1 = 0;
                for (int sg = 0; sg < wave * 2; ++sg) { b0 += wcnt[sg * 32 + e0]; b1 += wcnt[sg * 32 + e1]; }
                b1 += wcnt[(wave * 2) * 32 + e1];
                EIDX[tok * 2] = e0; EIDX[tok * 2 + 1] = e1; EW[tok * 2] = w0; EW[tok * 2 + 1] = w1; RANK[tok * 2] = b0 + rk0; RANK[tok * 2 + 1] = b1 + rk1;
            }
            if (tid < 32) { int s = 0; for (int sg = 0; sg < 8; ++sg) s += wcnt[sg * 32 + tid]; CNT[ch * 32 + tid] = s; }
            __syncthreads();
        }
    }
    SEAM(7);
    if (IN(8)) {
        LAS int* tot = (LAS int*)(lds + RING_OFF); LAS int* pbase = tot + 32; LAS int* mybase = tot + 72;
        const int* EIDX = WSP(int, WS_EIDX); const float* EW = WSP(float, WS_EW); const int* RANK = WSP(int, WS_RANK); const int* CNT = WSP(int, WS_CNT);
        int* TILEE = WSP(int, WS_TILEE); int* SLOTTOK = WSP(int, WS_SLOTTOK); float* SLOTW = WSP(float, WS_SLOTW);
        for (int ch = bx; ch < T / 256; ch += G) {
            if (tid < 32) { int t = 0, mb = 0; for (int c = 0; c < T / 256; ++c) { const int v = CNT[c * 32 + tid]; if (c < ch) mb += v; t += v; } tot[tid] = t; mybase[tid] = mb; }
            __syncthreads();
            if (tid == 0) { int pb = 0; for (int e = 0; e < NEXP; ++e) { pbase[e] = pb; pb += ((tot[e] + 255) >> 8) << 8; } pbase[32] = pb; }
            __syncthreads();
            if (tid < 256) { const int tok = ch * 256 + tid;
#pragma unroll
                for (int k = 0; k < 2; ++k) { const int e = EIDX[tok * 2 + k]; const int slot = pbase[e] + mybase[e] + RANK[tok * 2 + k]; SLOTTOK[slot] = tok * 2 + k; SLOTW[slot] = EW[tok * 2 + k]; } }
            if (ch < NEXP) { const int e = ch; const int endp = pbase[e] + (((tot[e] + 255) >> 8) << 8);
                for (int s = pbase[e] + tot[e] + tid; s < endp; s += NWAVES * 64) { SLOTTOK[s] = -1; SLOTW[s] = 0.f; } }
            if (ch == 0) { if (tid < 32) { const int nte = (tot[tid] + 255) >> 8; for (int tl = 0; tl < nte; ++tl) TILEE[(pbase[tid] >> 8) + tl] = tid; }
                           if (tid == 0) TILEE[MAXTILES] = pbase[32] >> 8; }
            __syncthreads();
        }
    }
    SEAM(8);
    if (IN(9)) {
        const int* TILEE = WSP(int, WS_TILEE); const int* SLOTTOK = WSP(int, WS_SLOTTOK);
        const int ntiles = TILEE[MAXTILES];
        pg8::Gemm g{WSP(bf16, WS_X1B), WSP(bf16, WS_WGU), T, 512, DM, SLOTTOK}; epi::MoeOrder S{TILEE, ntiles, 2, G, bx};
        epi::EpiGateUp E{SLOTTOK, WSP(float, WS_RSTD2), WSP(bf16, WS_HID)};
        pg8::gemm_phase<epi::EpiGateUp, epi::MoeOrder, true, true>(lds + RING_OFF, g, S, E);
    }
    SEAM(9);
    if (IN(10)) {
        const int* TILEE = WSP(int, WS_TILEE);
        const int ntiles = TILEE[MAXTILES];
        pg8::Gemm g{WSP(bf16, WS_HID), WSP(bf16, WS_WD), MAXTILES * 256, 1024, DEXP, nullptr}; epi::MoeOrder S{TILEE, ntiles, 4, G, bx};
        epi::EpiDown E{WSP(int, WS_SLOTTOK), WSP(float, WS_SLOTW), WSP(bf16, WS_YB)};
        pg8::gemm_phase<epi::EpiDown, epi::MoeOrder, true, false>(lds + RING_OFF, g, S, E);
    }
    SEAM(10);
    if (IN(11)) {
        const float* X1 = WSP(float, WS_X1); const bf16* YB = WSP(bf16, WS_YB); float* outp = KA->out;
        f32x4 gn[4];
#pragma unroll
        for (int j = 0; j < 4; ++j) gn[j] = *((const GAS f32x4*)FIN(19) + lane + 64 * j);
        for (int m = gw; m < T; m += NGW) {
            const GAS f32x4* xr = (const GAS f32x4*)(X1 + (size_t)m * DM) + lane;
            const GAS u32x2v* y0 = (const GAS u32x2v*)(YB + (size_t)(2 * m) * DM) + lane; const GAS u32x2v* y1 = (const GAS u32x2v*)(YB + (size_t)(2 * m + 1) * DM) + lane;
            f32x4 v[4]; float s2 = 0.f;
#pragma unroll
            for (int j = 0; j < 4; ++j) { v[j] = xr[64 * j]; const u32x2v a = y0[64 * j], b = y1[64 * j];
#ifndef DBG_NOMOE
                v[j].x += bflo(a.x) + bflo(b.x); v[j].y += bfhi(a.x) + bfhi(b.x); v[j].z += bflo(a.y) + bflo(b.y); v[j].w += bfhi(a.y) + bfhi(b.y);
#endif
                s2 += (v[j].x * v[j].x + v[j].y * v[j].y) + (v[j].z * v[j].z + v[j].w * v[j].w); }
            const float rstd = rsqrtf(wave_sum(s2) * (1.f / DM) + EPS);
            GAS f32x4* orow = (GAS f32x4*)(outp + (size_t)m * DM) + lane;
#pragma unroll
            for (int j = 0; j < 4; ++j) orow[64 * j] = v[j] * rstd * gn[j];
        }
    }
#undef IN
#undef SEAM
}

#ifndef MK_N_LAUNCHES
#define MK_N_LAUNCHES 1
#endif
extern "C" void kernel_launch(void* const* d_in, const int* in_sizes, int n_in, void* d_out, int out_size, void* d_ws, size_t ws_size, hipStream_t stream) {
    static int grid = 0;
    if (grid == 0) {
        if (n_in != 20 || in_sizes[0] != T * DM || out_size != T * DM || ws_size < WS_END) { fprintf(stderr, "kernel_launch: unexpected shapes (n_in %d, in0 %d, out %d, ws %zu)\n", n_in, n_in > 0 ? in_sizes[0] : -1, out_size, ws_size); grid = -1; return; }
        int dev = 0, cus = 0, per_cu = 0;
        if (hipGetDevice(&dev) != hipSuccess || hipDeviceGetAttribute(&cus, hipDeviceAttributeMultiprocessorCount, dev) != hipSuccess) { grid = -1; return; }
        if (hipFuncSetAttribute((const void*)fwd_kernel, hipFuncAttributeMaxDynamicSharedMemorySize, LDS_BYTES) != hipSuccess) { fprintf(stderr, "kernel_launch: hipFuncSetAttribute failed\n"); grid = -1; return; }
        if (hipOccupancyMaxActiveBlocksPerMultiprocessor(&per_cu, (const void*)fwd_kernel, NWAVES * 64, LDS_BYTES) != hipSuccess || per_cu < 1) { fprintf(stderr, "kernel_launch: occupancy query reports %d blocks per CU\n", per_cu); }
        (void)hipGetLastError();
        grid = cus;
    }
    if (grid < 0) return;
    if (hipMemsetAsync((char*)d_ws + WS_CTL, 0, CTL_ZERO_BYTES, stream) != hipSuccess) return;
    Args a{};
    for (int i = 0; i < 20; ++i) a.in[i] = d_in[i];
    a.out = (float*)d_out; a.ws = (unsigned char*)d_ws;
    if (MK_N_LAUNCHES == 1) { a.ph_lo = 0; a.ph_hi = NPHASE; hipLaunchKernelGGL(fwd_kernel, dim3(grid), dim3(NWAVES * 64), LDS_BYTES, stream, a); }
    else for (int p = 0; p < NPHASE; ++p) { a.ph_lo = p; a.ph_hi = p + 1; hipLaunchKernelGGL(fwd_kernel, dim3(grid), dim3(NWAVES * 64), LDS_BYTES, stream, a); }
}
```

```cpp
#include <hip/hip_runtime.h>
#include <cstdio>
#include <cstdint>
#include <cmath>
namespace pg8 {
#define PG8_LAS __attribute__((address_space(3)))
typedef unsigned short bf16_t;
typedef short bf16x8 __attribute__((ext_vector_type(8)));
typedef float f32x4 __attribute__((ext_vector_type(4)));
typedef unsigned u32x4 __attribute__((ext_vector_type(4)));
constexpr int BM = 256, BK = 64, HALF = 128, HTB = HALF * BK * 2  , STAGE_BYTES = 8 * HTB, NXCD = 8, WGM = 8;

__host__ __device__ __forceinline__ int lds_byte(int r, int c) { const int st = (r >> 4) * 2 + (c >> 5), rr = r & 15, cc = c & 31, ob = rr * 64 + cc * 2; return st * 1024 + (ob ^ (((ob >> 9) & 1) << 5)); }
__host__ __device__ __forceinline__ void stage_rc(int b, int& R, int& C) { const int st = b / 1024, sb = b % 1024, swz = sb ^ (((sb >> 9) & 1) << 5); R = (st >> 1) * 16 + swz / 64; C = (st & 1) * 32 + (swz % 64) / 2; }
__host__ __device__ __forceinline__ int perm32(int rho) { const int n = rho >> 4, i = rho & 15; return 8 * (i >> 2) + 4 * n + (i & 3); }

struct Unit { int pm, pn; };
struct Gemm { const bf16_t* A; const bf16_t* Bt; int M, N, K; const int* rowtok; };

struct StaticOrder {
    int nM, nN, nwg, G, c;
    __host__ __device__ __forceinline__ void init(int M, int N, int G_, int c_) { nM = M / BM; nN = N / BM; nwg = nM * nN; G = G_; c = c_; }
    __host__ __device__ __forceinline__ bool next(int i, Unit& u) const {
        const long L = (long)i * G + c; if (L >= nwg) return false;
        int wgid = (int)L; { const int q = nwg / NXCD, r = nwg % NXCD, xcd = wgid % NXCD, off = wgid / NXCD; wgid = (xcd < r ? xcd * (q + 1) : r * (q + 1) + (xcd - r) * q) + off; }
        const int nig = WGM * nN, gid = wgid / nig, fm = gid * WGM, gsz = (nM - fm) < WGM ? (nM - fm) : WGM;
        u.pm = fm + ((wgid % nig) % gsz); u.pn = (wgid % nig) / gsz; return true;
    }
    __device__ __forceinline__ void a_ready(const Unit&) const {}
    __device__ __forceinline__ void done(const Unit&) const {}
};

typedef float f32x2_t __attribute__((ext_vector_type(2))); typedef __bf16 bf16x2_t __attribute__((ext_vector_type(2)));
__device__ __forceinline__ unsigned cvt_pk_bf16(float lo, float hi) { f32x2_t v = {lo, hi}; bf16x2_t b = __builtin_convertvector(v, bf16x2_t); return __builtin_bit_cast(unsigned, b); }

template <class Epi, class Sched, bool ALIGN_EPI, bool GATHER>
__device__ __forceinline__ void gemm_phase(PG8_LAS unsigned char* lds, const Gemm g, const Sched& S, const Epi& E) {
    const int tid = threadIdx.x, wid = __builtin_amdgcn_readfirstlane(tid >> 6), lane = tid & 63, wr = wid >> 2, wc = wid & 3, fr = lane & 15, fq = lane >> 4;
    const int K = g.K, nt = K / BK;
    unsigned voffA[2], voffB[2]; int RA[2], CA[2];
#pragma unroll
    for (int i = 0; i < 2; ++i) { int R, C; stage_rc(tid * 16 + i * 8192, R, C); const int Rb = Epi::PERM ? ((R & ~31) + perm32(R & 31)) : R;
        voffA[i] = (unsigned)(R * K + C) * 2u; voffB[i] = (unsigned)(Rb * K + C) * 2u; RA[i] = R; CA[i] = C; }
    const size_t kstep = (size_t)(BK * 2);
    const size_t hstep = (size_t)HALF * K * 2;
    const size_t tstep = 2 * hstep;
    const unsigned ldsw = (unsigned)wid * 1024u;
    const int aoff = lds_byte(wr * 64 + fr, fq * 8), boff = lds_byte(wc * 32 + fr, fq * 8);
#define PG8_SA(b, h) (((b) * 2 + (h)) * HTB)
#define PG8_SB(b, h) ((4 + (b) * 2 + (h)) * HTB)
#define PG8_STAGE(bufoff, gbase, voff) do { _Pragma("unroll") for (int _i = 0; _i < 2; ++_i) \
        __builtin_amdgcn_global_load_lds((const unsigned*)((const char*)(gbase) + (voff)[_i]), (PG8_LAS unsigned*)(lds + (bufoff) + ldsw + _i * 8192), 16, 0, 0); } while (0)
#define PG8_STAGE_A(b, h, p, OFF) do { if constexpr (GATHER) { PG8_STAGE(PG8_SA(b, h), (p), OFF[h]); } else { PG8_STAGE(PG8_SA(b, h), (p) + (h) * hstep, voffA); } } while (0)
#define PG8_LDA(dst, b, h) do { _Pragma("unroll") for (int m = 0; m < 4; ++m) _Pragma("unroll") for (int k = 0; k < 2; ++k) dst[m][k] = *(const PG8_LAS bf16x8*)(lds + PG8_SA(b, h) + aoff + m * 2048 + k * 1024); } while (0)
#define PG8_LDB(dst, b, h) do { _Pragma("unroll") for (int n = 0; n < 2; ++n) _Pragma("unroll") for (int k = 0; k < 2; ++k) dst[n][k] = *(const PG8_LAS bf16x8*)(lds + PG8_SB(b, h) + boff + n * 2048 + k * 1024); } while (0)
#define PG8_MMA(ai, bj, At, Bt) do { __builtin_amdgcn_s_setprio(1); _Pragma("unroll") for (int m = 0; m < 4; ++m) _Pragma("unroll") for (int n = 0; n < 2; ++n) _Pragma("unroll") for (int k = 0; k < 2; ++k) \
        acc[ai][bj][m][n] = __builtin_amdgcn_mfma_f32_16x16x32_bf16(Bt[n][k], At[m][k], acc[ai][bj][m][n], 0, 0, 0); __builtin_amdgcn_s_setprio(0); } while (0)
#define PG8_WAIT_V(n) asm volatile("s_waitcnt vmcnt(" #n ")" ::: "memory")
#define PG8_WAIT_L(n) asm volatile("s_waitcnt lgkmcnt(" #n ")" ::: "memory")
#define PG8_BAR __builtin_amdgcn_s_barrier()
#define PG8_SCHED __builtin_amdgcn_sched_barrier(0)
#define PG8_GOFF(dst, pm_) do { _Pragma("unroll") for (int _h = 0; _h < 2; ++_h) _Pragma("unroll") for (int _i = 0; _i < 2; ++_i) { \
        int _t = g.rowtok[(pm_) * BM + _h * HALF + RA[_i]]; _t = _t < 0 ? 0 : (_t >> 1); dst[_h][_i] = (unsigned)(_t * K + CA[_i]) * 2u; } } while (0)
    Unit cur, nxt; int ui = 0;
    if (!S.next(0, cur)) return;
    f32x4 acc[2][2][4][2];
    if constexpr (Epi::HAS_INIT) { E.init(acc, cur, wr, wc, fr, fq); } else {
#pragma unroll
    for (int a = 0; a < 2; ++a)
#pragma unroll
        for (int b = 0; b < 2; ++b)
#pragma unroll
            for (int m = 0; m < 4; ++m)
#pragma unroll
                for (int n = 0; n < 2; ++n) acc[a][b][m][n] = (f32x4){0.f, 0.f, 0.f, 0.f};
    }
    bf16x8 At[4][2], B0[2][2], B1[2][2];
    unsigned oC[2][2] = {{0u, 0u}, {0u, 0u}}, oN[2][2] = {{0u, 0u}, {0u, 0u}}, o2[2][2] = {{0u, 0u}, {0u, 0u}};
    if constexpr (GATHER) { PG8_GOFF(oC, cur.pm); }
    const char* cA = GATHER ? (const char*)g.A : (const char*)g.A + (size_t)cur.pm * tstep; const char* cB = (const char*)g.Bt + (size_t)cur.pn * tstep;
    S.a_ready(cur);
    PG8_STAGE(PG8_SB(0, 0), cB, voffB); PG8_STAGE(PG8_SB(0, 1), cB + hstep, voffB); PG8_STAGE_A(0, 0, cA, oC); PG8_STAGE_A(0, 1, cA, oC);
    if (wr == 1) PG8_BAR;
    PG8_WAIT_V(2); PG8_BAR;
    PG8_STAGE(PG8_SB(1, 0), cB + kstep, voffB); PG8_STAGE_A(1, 0, cA + kstep, oC); PG8_STAGE(PG8_SB(1, 1), cB + hstep + kstep, voffB);
    PG8_WAIT_V(6); PG8_BAR;
    for (;;) {
        const bool has_next = S.next(ui + 1, nxt);
        if constexpr (GATHER) { if (has_next) { PG8_GOFF(oN, nxt.pm); } }
        const char* nA = GATHER ? cA : (has_next ? (const char*)g.A + (size_t)nxt.pm * tstep : cA); const char* nB = has_next ? (const char*)g.Bt + (size_t)nxt.pn * tstep : cB;
#pragma clang loop unroll(disable)
        for (int t = 0; t < nt; t += 2) {
            const bool last = (t == nt - 2);
            const char* a1 = cA + (size_t)(t + 1) * kstep;
            const char* a2 = last ? nA : cA + (size_t)(t + 2) * kstep; const char* b2 = last ? nB : cB + (size_t)(t + 2) * kstep;
            const char* a3 = a2 + kstep; const char* b3 = b2 + kstep;
            if constexpr (GATHER) { const bool sel = last && has_next;
#pragma unroll
                for (int h = 0; h < 2; ++h)
#pragma unroll
                    for (int i = 0; i < 2; ++i) o2[h][i] = sel ? oN[h][i] : oC[h][i]; }
            if (last && has_next) S.a_ready(nxt);
            if constexpr (Epi::HAS_MIDK) { if (t == Epi::MIDT) E.midk(acc, cur, wr, wc, fr, fq); }
            PG8_LDB(B0, 0, 0); PG8_LDB(B1, 0, 1); PG8_SCHED; PG8_LDA(At, 0, 0); PG8_STAGE_A(1, 1, a1, oC);
            PG8_WAIT_V(8); PG8_WAIT_L(0); PG8_BAR; PG8_MMA(0, 0, At, B0); PG8_MMA(0, 1, At, B1); PG8_BAR; PG8_SCHED;
            PG8_LDA(At, 0, 1); PG8_STAGE(PG8_SB(0, 0), b2, voffB); PG8_STAGE(PG8_SB(0, 1), b2 + hstep, voffB); PG8_STAGE_A(0, 0, a2, o2);
            PG8_WAIT_V(8); PG8_WAIT_L(0); PG8_BAR; PG8_MMA(1, 0, At, B0); PG8_MMA(1, 1, At, B1); PG8_BAR; PG8_SCHED;
            PG8_LDB(B0, 1, 0); PG8_LDB(B1, 1, 1); PG8_SCHED; PG8_LDA(At, 1, 0); PG8_STAGE_A(0, 1, a2, o2);
            PG8_WAIT_V(8); PG8_WAIT_L(0); PG8_BAR; PG8_MMA(0, 0, At, B0); PG8_MMA(0, 1, At, B1); PG8_BAR; PG8_SCHED;
            PG8_LDA(At, 1, 1); PG8_STAGE(PG8_SB(1, 0), b3, voffB); PG8_STAGE(PG8_SB(1, 1), b3 + hstep, voffB); PG8_STAGE_A(1, 0, a3, o2);
            PG8_WAIT_V(8); PG8_WAIT_L(0); PG8_BAR; PG8_MMA(1, 0, At, B0); PG8_MMA(1, 1, At, B1); PG8_BAR; PG8_SCHED;
        }
        if constexpr (ALIGN_EPI) { if (wr == 0) PG8_BAR; }
        E(acc, cur, wr, wc, fr, fq); S.done(cur);
        if (!has_next) break;
        if constexpr (Epi::HAS_INIT) { E.init(acc, nxt, wr, wc, fr, fq); } else {
#pragma unroll
        for (int a = 0; a < 2; ++a)
#pragma unroll
            for (int b = 0; b < 2; ++b)
#pragma unroll
                for (int m = 0; m < 4; ++m)
#pragma unroll
                    for (int n = 0; n < 2; ++n) acc[a][b][m][n] = (f32x4){0.f, 0.f, 0.f, 0.f};
        }
        cur = nxt; cA = nA; cB = nB; ++ui;
        if constexpr (GATHER) {
#pragma unroll
            for (int h = 0; h < 2; ++h)
#pragma unroll
                for (int i = 0; i < 2; ++i) oC[h][i] = oN[h][i]; }
        if constexpr (ALIGN_EPI) { if (wr == 1) PG8_BAR; }
    }
    PG8_WAIT_V(0);
    if constexpr (!ALIGN_EPI) { if (wr == 0) PG8_BAR; }
    PG8_BAR;
#undef PG8_SA
#undef PG8_SB
#undef PG8_STAGE
#undef PG8_STAGE_A
#undef PG8_LDA
#undef PG8_LDB
#undef PG8_MMA
#undef PG8_WAIT_V
#undef PG8_WAIT_L
#undef PG8_BAR
#undef PG8_SCHED
#undef PG8_GOFF
}
}

constexpr int NWAVES = 8;
constexpr int BATCH = 32, SEQ = 2048, DM = 1024, T = BATCH * SEQ;
constexpr int NH = 8, HD = 64, SBW = 512, MLAW = 512, QLORA = 256, KVLORA = 128, ROPE = 32, NOPE = 64, QKD = 96;
constexpr int INC = 1952, INP = 2048;
constexpr int NEXP = 32, NGRP = 4, EPG = 8, DEXP = 256;
constexpr int MAXTILES = 544;
constexpr float EPS = 1e-6f;
constexpr float LOG2E = 1.4426950408889634f;
constexpr float SB_C2 = 0.125f * LOG2E;
constexpr float YB_SCALE = 8.0f;
constexpr float MLA_C2 = 0.10206207261596575f * LOG2E;

constexpr size_t MiB = 1u << 20;
constexpr size_t WS_CTL = 0, CTL_ZERO_BYTES = 1 * MiB;
constexpr size_t WS_WIN = 2 * MiB;
constexpr size_t WS_WUQ = 6 * MiB;
constexpr size_t WS_WUKV = 7 * MiB;
constexpr size_t WS_WOUT = 8 * MiB;
constexpr size_t WS_WR = 10 * MiB;
constexpr size_t WS_WGU = 11 * MiB;
constexpr size_t WS_WD = 43 * MiB;
constexpr size_t WS_TAB = 60 * MiB;
constexpr size_t WS_SSQQ = 68 * MiB;
constexpr size_t WS_SSQKV = 69 * MiB;
constexpr size_t WS_OSS = 70 * MiB;
constexpr size_t WS_SSQ2 = 74 * MiB;
constexpr size_t WS_RSTD2 = 78 * MiB;
constexpr size_t WS_INV1 = 78 * MiB + 512 * 1024;
constexpr size_t WS_RS3 = 105 * MiB;
constexpr size_t WS_EIDX = 79 * MiB;
constexpr size_t WS_EW = 80 * MiB;
constexpr size_t WS_RANK = 81 * MiB;
constexpr size_t WS_CNT = 82 * MiB;
constexpr size_t WS_TILEE = 82 * MiB + 65536;
constexpr size_t WS_SLOTTOK = 83 * MiB;
constexpr size_t WS_SLOTW = 84 * MiB;
constexpr size_t WS_SLOTRS = 84 * MiB + 640 * 1024;
constexpr size_t WS_LOGITS = 85 * MiB;
constexpr size_t WS_KROPE = 101 * MiB;
constexpr size_t WS_H = 106 * MiB;
constexpr size_t WS_QM = 874 * MiB;
constexpr size_t WS_X1B = 234 * MiB;
constexpr size_t WS_QS = 234 * MiB, WS_KS = 298 * MiB, WS_VS = 362 * MiB;
constexpr size_t WS_CQ = 426 * MiB;
constexpr size_t WS_CKV = 458 * MiB;
constexpr size_t WS_X1 = 234 * MiB;
constexpr size_t WS_KVM = 490 * MiB;
constexpr size_t WS_HID = 490 * MiB;
constexpr size_t WS_O = 618 * MiB;
constexpr size_t WS_YB = 618 * MiB;
constexpr size_t WS_END = 970 * MiB;
constexpr int CW_BAR = 4096;
constexpr int CW_LATE = 16384, CW_LATE_TMO = 16384 + 64 * 64;

constexpr int RING_OFF = 0, RING_BYTES = 131072;
constexpr int LDSCTL_OFF = RING_BYTES, MISC_OFF = LDSCTL_OFF + 320;
constexpr int LDS_BYTES = 147456;

#define GAS __attribute__((address_space(1)))
#define LAS __attribute__((address_space(3)))
typedef unsigned short bf16;
typedef unsigned v4u __attribute__((ext_vector_type(4)));
typedef float f32x4 __attribute__((ext_vector_type(4)));
typedef short bf16x8 __attribute__((ext_vector_type(8)));
typedef GAS unsigned gu32;
typedef GAS unsigned long long gu64;
#define RLX_AGENT __ATOMIC_RELAXED, __HIP_MEMORY_SCOPE_AGENT
#define LDS_WAIT() asm volatile("s_waitcnt lgkmcnt(0)" ::: "memory")
#define VM_WAIT() asm volatile("s_waitcnt vmcnt(0)" ::: "memory")
__device__ __forceinline__ unsigned long long rt() { return __builtin_amdgcn_s_memrealtime(); }
__device__ __forceinline__ unsigned f2bf(float f) { unsigned u = __builtin_bit_cast(unsigned, f); return (u + 0x7fffu + ((u >> 16) & 1u)) >> 16; }
__device__ __forceinline__ unsigned pk2(float lo, float hi) { return f2bf(lo) | (f2bf(hi) << 16); }

#define XB_TMO      128
#define XB_XCNT(j)  (256  + 64 * (j))
#define XB_XSUB(j)  (1280 + 64 * (j))
#define XB_XGEN(j)  (2304 + 64 * (j))
#define XB_TOP      3328
#define XB_TOPGEN   3392
#define XCD_BAR_WORDS 3456
#define XB_SPIN_CAP (1u << 18)

__device__ __forceinline__ unsigned xb_ld(unsigned* p)              { return __hip_atomic_load(p, __ATOMIC_RELAXED, __HIP_MEMORY_SCOPE_AGENT); }
__device__ __forceinline__ unsigned xb_add(unsigned* p, unsigned v) { return __hip_atomic_fetch_add(p, v, __ATOMIC_RELAXED, __HIP_MEMORY_SCOPE_AGENT); }
__device__ __forceinline__ unsigned xb_xcc_id() { return (unsigned)__builtin_amdgcn_s_getreg((3 << 11) | 20) & 0xFu; }
#define XB_SPIN(cond, bar) do { unsigned _sp = 0; while (cond) { __builtin_amdgcn_s_sleep(1); \
    if ((++_sp & 255u) == 0u) { if (xb_ld(&(bar)[XB_TMO])) break; if (_sp > XB_SPIN_CAP) { atomicAdd(&(bar)[XB_TMO], 1u); break; } } } } while (0)

struct XcdBarrier {
    unsigned* bar; unsigned x;
    volatile LAS unsigned* st;
};

__device__ __forceinline__ XcdBarrier xcd_barrier_post(unsigned* bar, volatile LAS unsigned* st) {
    XcdBarrier b; b.bar = bar; b.x = xb_xcc_id(); b.st = st;
    if (threadIdx.x == 0) (void)xb_add(&bar[XB_XCNT(b.x)], 1u);
    return b;
}
__device__ __forceinline__ void xcd_barrier_complete(unsigned* bar, unsigned x, unsigned& nloc, unsigned& nx) {
    const unsigned G = gridDim.x * gridDim.y * gridDim.z;
    unsigned sum, cnt, mine, sp = 0u;
    for (;;) {
        sum = 0u; cnt = 0u; mine = 0u;
#pragma unroll
        for (unsigned j = 0; j < 16; ++j) { const unsigned c = xb_ld(&bar[XB_XCNT(j)]); sum += c; cnt += (c > 0u) ? 1u : 0u; mine = (j == x) ? c : mine; }
        if (sum == G) break;
        __builtin_amdgcn_s_sleep(1);
        if ((++sp & 255u) == 0u) { if (xb_ld(&bar[XB_TMO])) break; if (sp > XB_SPIN_CAP) { atomicAdd(&bar[XB_TMO], 1u); break; } }
    }
    nloc = mine > 0u ? mine : 1u; nx = cnt > 0u ? cnt : 1u;
}

__device__ __forceinline__ void xcd_barrier(const XcdBarrier& b) {
    asm volatile("s_waitcnt vmcnt(0)" ::: "memory");
    __syncthreads();
    if (threadIdx.x == 0) {
        unsigned* bar = b.bar;
        __builtin_amdgcn_s_waitcnt(0);
        unsigned nloc = b.st[0], nx = b.st[1];
        if (nloc == 0u) { xcd_barrier_complete(bar, b.x, nloc, nx); b.st[0] = nloc; b.st[1] = nx; }
        const unsigned old = xb_add(&bar[XB_XSUB(b.x)], 1u);
        const unsigned gen = old / nloc;
        if (old + 1u == (gen + 1u) * nloc) {
            __builtin_amdgcn_fence(__ATOMIC_RELEASE, "agent");
            asm volatile("s_waitcnt vmcnt(0)" ::: "memory");
            const unsigned og = xb_add(&bar[XB_TOP], 1u);
            const unsigned tg = og / nx;
            if (og + 1u == (tg + 1u) * nx) xb_add(&bar[XB_TOPGEN], 1u);
            else XB_SPIN(xb_ld(&bar[XB_TOPGEN]) == tg, bar);
            __builtin_amdgcn_fence(__ATOMIC_ACQUIRE, "agent");
            xb_add(&bar[XB_XGEN(b.x)], 1u);
            asm volatile("s_waitcnt vmcnt(0)" ::: "memory");
        } else {
            XB_SPIN(xb_ld(&bar[XB_XGEN(b.x)]) == gen, bar);
            __builtin_amdgcn_fence(__ATOMIC_ACQUIRE, "agent");
            asm volatile("s_waitcnt vmcnt(0)" ::: "memory");
        }
    }
    __syncthreads();
}

typedef float f32x2v __attribute__((ext_vector_type(2)));
typedef unsigned u32x2v __attribute__((ext_vector_type(2)));
namespace epi {
using pg8::f32x4; using pg8::u32x4; using pg8::Unit; using pg8::bf16_t; using pg8::cvt_pk_bf16;
typedef float f32x2 __attribute__((ext_vector_type(2)));
typedef unsigned u32x2 __attribute__((ext_vector_type(2)));
__device__ __forceinline__ u32x4 pack8(const f32x4 a, const f32x4 b) { u32x4 w; w.x = cvt_pk_bf16(a[0], a[1]); w.y = cvt_pk_bf16(a[2], a[3]); w.z = cvt_pk_bf16(b[0], b[1]); w.w = cvt_pk_bf16(b[2], b[3]); return w; }
__device__ __forceinline__ float sq8(const f32x4 a, const f32x4 b) { return (a[0] * a[0] + a[1] * a[1]) + (a[2] * a[2] + a[3] * a[3]) + (b[0] * b[0] + b[1] * b[1]) + (b[2] * b[2] + b[3] * b[3]); }
__device__ __forceinline__ void rope8(f32x4& a, f32x4& b, const u32x4 tb) {
    const float c0 = __builtin_bit_cast(float, tb[0] << 16), s0 = __builtin_bit_cast(float, tb[0] & 0xffff0000u), c1 = __builtin_bit_cast(float, tb[1] << 16), s1 = __builtin_bit_cast(float, tb[1] & 0xffff0000u);
    const float c2 = __builtin_bit_cast(float, tb[2] << 16), s2 = __builtin_bit_cast(float, tb[2] & 0xffff0000u), c3 = __builtin_bit_cast(float, tb[3] << 16), s3 = __builtin_bit_cast(float, tb[3] & 0xffff0000u);
    f32x4 ra, rb;
    ra[0] = a[0] * c0 - a[1] * s0; ra[1] = a[1] * c0 + a[0] * s0;
    ra[2] = a[2] * c1 - a[3] * s1; ra[3] = a[3] * c1 + a[2] * s1;
    rb[0] = b[0] * c2 - b[1] * s2; rb[1] = b[1] * c2 + b[0] * s2;
    rb[2] = b[2] * c3 - b[3] * s3; rb[3] = b[3] * c3 + b[2] * s3;
    a = ra; b = rb;
}

struct EpiProj {
    static constexpr bool PERM = true, HAS_INIT = false, HAS_MIDK = false;
    bf16_t *QKV, *CQ, *CKV, *KROPE; float *SSQQ, *SSQKV; const unsigned* TAB;
    __device__ __forceinline__ void operator()(const f32x4 (&acc)[2][2][4][2], const Unit& u, int wr, int wc, int fr, int fq) const {
        const int pn = u.pn; int rowv = u.pm * 256 + wr * 64 + fr;
        if (pn < 6) {
            bf16_t* dst = QKV + (size_t)(pn >> 1) * ((size_t)T * 512) + (pn & 1) * 256 + wc * 32 + 8 * fq; const float sc = (pn < 2) ? SB_C2 : 1.0f;
#pragma unroll
            for (int ai = 0; ai < 2; ++ai)
#pragma unroll
                for (int m = 0; m < 4; ++m) { asm volatile("" : "+v"(rowv)); const int row = rowv; rowv += (m == 3) ? 80 : 16;
#pragma unroll
                    for (int bj = 0; bj < 2; ++bj) *(u32x4*)(dst + (size_t)row * 512 + bj * 128) = pack8(acc[ai][bj][m][0] * sc, acc[ai][bj][m][1] * sc); }
        } else if (pn == 6) {
#pragma unroll
            for (int ai = 0; ai < 2; ++ai)
#pragma unroll
                for (int m = 0; m < 4; ++m) { asm volatile("" : "+v"(rowv)); const int row = rowv; rowv += (m == 3) ? 80 : 16; float s = 0.f;
#pragma unroll
                    for (int bj = 0; bj < 2; ++bj) { const int c = bj * 128 + wc * 32 + 8 * fq;
                        *(u32x4*)(CQ + (size_t)row * 256 + c) = pack8(acc[ai][bj][m][0], acc[ai][bj][m][1]); s += sq8(acc[ai][bj][m][0], acc[ai][bj][m][1]); }
                    s += __shfl_xor(s, 16); s += __shfl_xor(s, 32);
                    if (fq == 0) SSQQ[(size_t)row * 4 + wc] = s; }
        } else {
#pragma unroll
            for (int ai = 0; ai < 2; ++ai)
#pragma unroll
                for (int m = 0; m < 4; ++m) { asm volatile("" : "+v"(rowv)); const int row = rowv; rowv += (m == 3) ? 80 : 16;
                    { const int c = wc * 32 + 8 * fq;
                      *(u32x4*)(CKV + (size_t)row * 128 + c) = pack8(acc[ai][0][m][0], acc[ai][0][m][1]);
                      float s = sq8(acc[ai][0][m][0], acc[ai][0][m][1]); s += __shfl_xor(s, 16); s += __shfl_xor(s, 32);
                      if (fq == 0) SSQKV[(size_t)row * 4 + wc] = s; }
                    if (wc == 0) {
                        f32x4 a = acc[ai][1][m][0], b = acc[ai][1][m][1];
                        rope8(a, b, *(const u32x4*)(TAB + (size_t)row * 16 + 4 * fq));
                        *(u32x4*)(KROPE + (size_t)row * 32 + 8 * fq) = pack8(a, b);
                    }
                    if (m & 1) asm volatile("" ::: "memory"); }
        }
    }
};

struct EpiQup {
    static constexpr bool PERM = true, HAS_INIT = false, HAS_MIDK = false;
    bf16_t* QM; const float* SSQQ; const unsigned* TAB;
    __device__ __forceinline__ void operator()(const f32x4 (&acc)[2][2][4][2], const Unit& u, int wr, int wc, int fr, int fq) const {
        const int row0 = u.pm * 256 + wr * 64 + fr;
        float rs[8];
#pragma unroll
        for (int i = 0; i < 8; ++i) { const f32x4 ss = *(const f32x4*)(SSQQ + (size_t)(row0 + (i >> 2) * 128 + (i & 3) * 16) * 4); rs[i] = rsqrtf(((ss[0] + ss[1]) + (ss[2] + ss[3])) * (1.0f / QLORA) + EPS) * MLA_C2; }
#pragma unroll
        for (int bj = 0; bj < 2; ++bj) {
            const int cc = u.pn * 256 + bj * 128 + wc * 32 + 8 * fq, jo = cc % QKD - NOPE;
            u32x4 tb[8];
            if (jo >= 0) { int rl = row0; asm volatile("" : "+v"(rl));
#pragma unroll
                for (int i = 0; i < 8; ++i) { tb[i] = *(const u32x4*)(TAB + (size_t)rl * 16 + (jo >> 1)); rl += ((i & 3) == 3) ? 80 : 16; }
            }
            int rowv = row0;
#pragma unroll
            for (int i = 0; i < 8; ++i) { const int ai = i >> 2, m = i & 3; asm volatile("" : "+v"(rowv)); const int row = rowv; rowv += (m == 3) ? 80 : 16;
                f32x4 a = acc[ai][bj][m][0] * rs[i], b = acc[ai][bj][m][1] * rs[i];
                if (jo >= 0) rope8(a, b, tb[i]);
                *(u32x4*)(QM + (size_t)row * 768 + cc) = pack8(a, b); }
            asm volatile("" ::: "memory");
        }
    }
};
struct EpiKVup {
    static constexpr bool PERM = true, HAS_INIT = false, HAS_MIDK = false;
    bf16_t* KVM; const float* SSQKV;
    __device__ __forceinline__ void operator()(const f32x4 (&acc)[2][2][4][2], const Unit& u, int wr, int wc, int fr, int fq) const {
        const int row0 = u.pm * 256 + wr * 64 + fr;
        float rs[8];
#pragma unroll
        for (int i = 0; i < 8; ++i) { const f32x4 ss = *(const f32x4*)(SSQKV + (size_t)(row0 + (i >> 2) * 128 + (i & 3) * 16) * 4); rs[i] = rsqrtf(((ss[0] + ss[1]) + (ss[2] + ss[3])) * (1.0f / KVLORA) + EPS); }
        int rowv = row0;
#pragma unroll
        for (int ai = 0; ai < 2; ++ai)
#pragma unroll
            for (int m = 0; m < 4; ++m) {
                asm volatile("" : "+v"(rowv)); const int row = rowv; rowv += (m == 3) ? 80 : 16;
#pragma unroll
                for (int bj = 0; bj < 2; ++bj) { const int c = u.pn * 256 + bj * 128 + wc * 32 + 8 * fq;
                    *(u32x4*)(KVM + (size_t)row * 1024 + c) = pack8(acc[ai][bj][m][0] * rs[ai * 4 + m], acc[ai][bj][m][1] * rs[ai * 4 + m]); }
            }
    }
};
struct EpiX1 {
    static constexpr bool PERM = true, HAS_INIT = true, HAS_MIDK = true; static constexpr int MIDT = 8;
    const bf16_t* H; const float* G1; bf16_t* X1B; float* SSQ2; const float* OSS; const float* INV1; __attribute__((address_space(3))) float* rsl;
    __device__ __forceinline__ void init(f32x4 (&acc)[2][2][4][2], const Unit& u, int wr, int wc, int fr, int fq) const {
        const int row0 = u.pm * 256 + wr * 64 + fr; const int c0 = u.pn * 256 + wc * 32 + 8 * fq;
        const bf16_t* hp = H + (size_t)row0 * 1024 + c0;
        f32x4 ig[2][2];
#pragma unroll
        for (int bj = 0; bj < 2; ++bj)
#pragma unroll
            for (int n = 0; n < 2; ++n) { const f32x4 gv = *(const f32x4*)(G1 + c0 + bj * 128 + 4 * n);
                ig[bj][n] = (f32x4){__builtin_amdgcn_rcpf(gv[0]), __builtin_amdgcn_rcpf(gv[1]), __builtin_amdgcn_rcpf(gv[2]), __builtin_amdgcn_rcpf(gv[3])}; }
#pragma unroll
        for (int ai = 0; ai < 2; ++ai)
#pragma unroll
            for (int m = 0; m < 4; ++m) {
                const int row = row0 + ai * 128 + m * 16; const f32x4* sp = (const f32x4*)(OSS + (size_t)row * 16);
                const f32x4 s0 = sp[0], s1 = sp[1], s2 = sp[2], s3 = sp[3];
                const float vs = (((s0[0] + s0[1]) + (s0[2] + s0[3])) + ((s1[0] + s1[1]) + (s1[2] + s1[3]))) * (1.f / 512.f) + 1e-6f, vm = (((s2[0] + s2[1]) + (s2[2] + s2[3])) + ((s3[0] + s3[1]) + (s3[2] + s3[3]))) * (1.f / 512.f) + 1e-6f;
                const float is = sqrtf(vs) * INV1[row];
                { __attribute__((address_space(3))) float* rp = rsl + (((wr * 4 + wc) * 8 + ai * 4 + m) * 16 + fr) * 2; rp[0] = rsqrtf(vs) * sqrtf(vm); rp[1] = rsqrtf(vm); }
#pragma unroll
                for (int bj = 0; bj < 2; ++bj) { const u32x4 hv = *(const u32x4*)(hp + (size_t)(ai * 128 + m * 16) * 1024 + bj * 128);
                    const f32x4 lo = {__builtin_bit_cast(float, hv[0] << 16), __builtin_bit_cast(float, hv[0] & 0xffff0000u), __builtin_bit_cast(float, hv[1] << 16), __builtin_bit_cast(float, hv[1] & 0xffff0000u)};
                    const f32x4 hi = {__builtin_bit_cast(float, hv[2] << 16), __builtin_bit_cast(float, hv[2] & 0xffff0000u), __builtin_bit_cast(float, hv[3] << 16), __builtin_bit_cast(float, hv[3] & 0xffff0000u)};
                    acc[ai][bj][m][0] = lo * ig[bj][0] * is; acc[ai][bj][m][1] = hi * ig[bj][1] * is; } }
    }
    __device__ __forceinline__ void midk(f32x4 (&acc)[2][2][4][2], const Unit& u, int wr, int wc, int fr, int fq) const {
        const int row0 = u.pm * 256 + wr * 64 + fr;
#pragma unroll
        for (int ai = 0; ai < 2; ++ai)
#pragma unroll
            for (int m = 0; m < 4; ++m) { const float rt = rsl[(((wr * 4 + wc) * 8 + ai * 4 + m) * 16 + fr) * 2];
#pragma unroll
                for (int bj = 0; bj < 2; ++bj) { acc[ai][bj][m][0] *= rt; acc[ai][bj][m][1] *= rt; } }
    }
    __device__ __forceinline__ void operator()(const f32x4 (&acc)[2][2][4][2], const Unit& u, int wr, int wc, int fr, int fq) const {
        const int row0 = u.pm * 256 + wr * 64 + fr;
        float rm[8];
#pragma unroll
        for (int i = 0; i < 8; ++i) rm[i] = rsl[(((wr * 4 + wc) * 8 + i) * 16 + fr) * 2 + 1];
        int rowv = row0;
#pragma unroll
        for (int ai = 0; ai < 2; ++ai)
#pragma unroll
            for (int m = 0; m < 4; ++m) {
                asm volatile("" : "+v"(rowv)); const int row = rowv; rowv += (m == 3) ? 80 : 16; float s = 0.f;
#pragma unroll
                for (int bj = 0; bj < 2; ++bj) { const size_t off = (size_t)row * 1024 + u.pn * 256 + bj * 128 + wc * 32 + 8 * fq;
                    const f32x4 a = acc[ai][bj][m][0] * rm[ai * 4 + m], b = acc[ai][bj][m][1] * rm[ai * 4 + m];
                    *(u32x4*)(X1B + off) = pack8(a, b); s += sq8(a, b); }
                s += __shfl_xor(s, 16); s += __shfl_xor(s, 32);
                if (fq == 0) SSQ2[(size_t)row * 16 + u.pn * 4 + wc] = s;
            }
    }
};
struct EpiRouter {
    static constexpr bool PERM = true, HAS_INIT = false, HAS_MIDK = false;
    const float* SSQ2; float* RSTD2; const float* BG; const float* BE; int* EIDX; float* EW; __attribute__((address_space(3))) int* ebuf;
    __device__ __forceinline__ void operator()(const f32x4 (&acc)[2][2][4][2], const Unit& u, int wr, int wc, int fr, int fq) const {
        if (wc != 0) return;
        const f32x4 bg = *(const f32x4*)BG, be0 = *(const f32x4*)(BE + 8 * fq), be1 = *(const f32x4*)(BE + 8 * fq + 4);
        int rowv = u.pm * 256 + wr * 64 + fr; int rlv = wr * 64 + fr;
#pragma unroll
        for (int ai = 0; ai < 2; ++ai)
#pragma unroll
            for (int m = 0; m < 4; ++m) {
                asm volatile("" : "+v"(rowv)); const int row = rowv; rowv += (m == 3) ? 80 : 16; const int rloc = rlv; rlv += (m == 3) ? 80 : 16;
                const f32x4 s0 = *(const f32x4*)(SSQ2 + (size_t)row * 16), s1 = *(const f32x4*)(SSQ2 + (size_t)row * 16 + 4), s2 = *(const f32x4*)(SSQ2 + (size_t)row * 16 + 8), s3 = *(const f32x4*)(SSQ2 + (size_t)row * 16 + 12);
                const float tot = (((s0[0] + s0[1]) + (s0[2] + s0[3])) + ((s1[0] + s1[1]) + (s1[2] + s1[3]))) + (((s2[0] + s2[1]) + (s2[2] + s2[3])) + ((s3[0] + s3[1]) + (s3[2] + s3[3])));
                const float rs = rsqrtf(tot * (1.0f / DM) + EPS);
                if (fq == 0) RSTD2[row] = rs;
                const f32x4 lg = acc[ai][0][m][0] * rs + bg;
                int gi = 0; float gm = lg[0];
                if (lg[1] > gm) { gm = lg[1]; gi = 1; } if (lg[2] > gm) { gm = lg[2]; gi = 2; } if (lg[3] > gm) { gm = lg[3]; gi = 3; }
                float gval = 1.0f / ((expf(lg[0] - gm) + expf(lg[1] - gm)) + (expf(lg[2] - gm) + expf(lg[3] - gm)));
                gi = __shfl(gi, fr); gval = __shfl(gval, fr);
                const f32x4 ea = acc[ai][1][m][0] * rs + be0, eb = acc[ai][1][m][1] * rs + be1;
                int i1 = 0; float m1 = ea[0];
                if (ea[1] > m1) { m1 = ea[1]; i1 = 1; } if (ea[2] > m1) { m1 = ea[2]; i1 = 2; } if (ea[3] > m1) { m1 = ea[3]; i1 = 3; }
                if (eb[0] > m1) { m1 = eb[0]; i1 = 4; } if (eb[1] > m1) { m1 = eb[1]; i1 = 5; } if (eb[2] > m1) { m1 = eb[2]; i1 = 6; } if (eb[3] > m1) { m1 = eb[3]; i1 = 7; }
                int i2 = -1; float m2 = -INFINITY;
                if (i1 != 0 && ea[0] > m2) { m2 = ea[0]; i2 = 0; } if (i1 != 1 && ea[1] > m2) { m2 = ea[1]; i2 = 1; } if (i1 != 2 && ea[2] > m2) { m2 = ea[2]; i2 = 2; } if (i1 != 3 && ea[3] > m2) { m2 = ea[3]; i2 = 3; }
                if (i1 != 4 && eb[0] > m2) { m2 = eb[0]; i2 = 4; } if (i1 != 5 && eb[1] > m2) { m2 = eb[1]; i2 = 5; } if (i1 != 6 && eb[2] > m2) { m2 = eb[2]; i2 = 6; } if (i1 != 7 && eb[3] > m2) { m2 = eb[3]; i2 = 7; }
                if (fq == gi) {
                    const float r = expf(m2 - m1);
                    const int e0 = fq * EPG + i1, e1 = fq * EPG + i2;
                    EIDX[row * 2] = e0; EIDX[row * 2 + 1] = e1; EW[row * 2] = gval / (1.0f + r); EW[row * 2 + 1] = gval * r / (1.0f + r);
                    ebuf[rloc * 2] = e0; ebuf[rloc * 2 + 1] = e1;
                }
                if (m & 1) asm volatile("" ::: "memory");
            }
    }
};
struct OneUnit {
    Unit u;
    __device__ __forceinline__ bool next(int i, Unit& o) const { if (i != 0) return false; o = u; return true; }
    __device__ __forceinline__ void a_ready(const Unit&) const {}
    __device__ __forceinline__ void done(const Unit&) const {}
};
struct EpiGateUp {
    static constexpr bool PERM = true, HAS_INIT = false, HAS_MIDK = false;
    const float* SLOTRS; bf16_t* HID;
    __device__ __forceinline__ void operator()(const f32x4 (&acc)[2][2][4][2], const Unit& u, int wr, int wc, int fr, int fq) const {
        const int pnl = u.pn & 1; const int slot0 = u.pm * 256 + wr * 64 + fr;
        float rsv[8];
#pragma unroll
        for (int i = 0; i < 8; ++i) rsv[i] = SLOTRS[slot0 + (i >> 2) * 128 + (i & 3) * 16];
        const bool odd = fq & 1;
        int rowv = slot0 + (odd ? 16 : 0);
#pragma unroll
        for (int ai = 0; ai < 2; ++ai)
#pragma unroll
            for (int j = 0; j < 2; ++j) {
                asm volatile("" : "+v"(rowv)); const int slot = rowv; rowv += (j == 1) ? 96 : 32; const float rs0 = rsv[ai * 4 + 2 * j], rs1 = rsv[ai * 4 + 2 * j + 1];
#pragma unroll
                for (int bj = 0; bj < 2; ++bj) { const int hc = pnl * 128 + bj * 64 + wc * 16 + 4 * (fq & 2);
                    const f32x4 gt0 = acc[ai][bj][2 * j][0] * rs0, up0 = acc[ai][bj][2 * j][1] * rs0, gt1 = acc[ai][bj][2 * j + 1][0] * rs1, up1 = acc[ai][bj][2 * j + 1][1] * rs1; f32x4 h0, h1;
#pragma unroll
                    for (int i = 0; i < 4; ++i) { h0[i] = gt0[i] * up0[i] * __builtin_amdgcn_rcpf(1.0f + __builtin_amdgcn_exp2f(-gt0[i] * LOG2E)); h1[i] = gt1[i] * up1[i] * __builtin_amdgcn_rcpf(1.0f + __builtin_amdgcn_exp2f(-gt1[i] * LOG2E)); }
                    const unsigned A0 = cvt_pk_bf16(h0[0], h0[1]), A1 = cvt_pk_bf16(h0[2], h0[3]), B0 = cvt_pk_bf16(h1[0], h1[1]), B1 = cvt_pk_bf16(h1[2], h1[3]);
                    const unsigned r0 = (unsigned)__shfl_xor((int)(odd ? A0 : B0), 16), r1 = (unsigned)__shfl_xor((int)(odd ? A1 : B1), 16);
                    const u32x4 o = {odd ? r0 : A0, odd ? r1 : A1, odd ? B0 : r0, odd ? B1 : r1};
                    *(u32x4*)(HID + (size_t)slot * 256 + hc) = o; }
            }
    }
};
struct EpiDown {
    static constexpr bool PERM = true, HAS_INIT = false, HAS_MIDK = false;
    const int* SLOTTOK; const float* SLOTW; unsigned char* YB;
    __device__ __forceinline__ void operator()(const f32x4 (&acc)[2][2][4][2], const Unit& u, int wr, int wc, int fr, int fq) const {
        const int pnl = u.pn & 3; const int slot0 = u.pm * 256 + wr * 64 + fr;
        int st[8]; float wv[8];
#pragma unroll
        for (int i = 0; i < 8; ++i) { st[i] = SLOTTOK[slot0 + (i >> 2) * 128 + (i & 3) * 16]; wv[i] = SLOTW[slot0 + (i >> 2) * 128 + (i & 3) * 16] * YB_SCALE; }
        const bool odd = fq & 1;
#pragma unroll
        for (int ai = 0; ai < 2; ++ai)
#pragma unroll
            for (int j = 0; j < 2; ++j) {
                const int i0 = ai * 4 + 2 * j, i1 = i0 + 1;
                const int sti = odd ? st[i1] : st[i0];
#pragma unroll
                for (int bj = 0; bj < 2; ++bj) {
                    const f32x4 a0 = acc[ai][bj][2 * j][0] * wv[i0], b0 = acc[ai][bj][2 * j][1] * wv[i0], a1 = acc[ai][bj][2 * j + 1][0] * wv[i1], b1 = acc[ai][bj][2 * j + 1][1] * wv[i1];
                    int A_lo = __builtin_amdgcn_cvt_pk_fp8_f32(a0[0], a0[1], 0, false); A_lo = __builtin_amdgcn_cvt_pk_fp8_f32(a0[2], a0[3], A_lo, true);
                    int A_hi = __builtin_amdgcn_cvt_pk_fp8_f32(b0[0], b0[1], 0, false); A_hi = __builtin_amdgcn_cvt_pk_fp8_f32(b0[2], b0[3], A_hi, true);
                    int B_lo = __builtin_amdgcn_cvt_pk_fp8_f32(a1[0], a1[1], 0, false); B_lo = __builtin_amdgcn_cvt_pk_fp8_f32(a1[2], a1[3], B_lo, true);
                    int B_hi = __builtin_amdgcn_cvt_pk_fp8_f32(b1[0], b1[1], 0, false); B_hi = __builtin_amdgcn_cvt_pk_fp8_f32(b1[2], b1[3], B_hi, true);
                    const int r_lo = __shfl_xor(odd ? A_lo : B_lo, 16), r_hi = __shfl_xor(odd ? A_hi : B_hi, 16);
                    const u32x4 o = {(unsigned)(odd ? r_lo : A_lo), (unsigned)(odd ? r_hi : A_hi), (unsigned)(odd ? B_lo : r_lo), (unsigned)(odd ? B_hi : r_hi)};
                    if (sti >= 0) *(u32x4*)(YB + (size_t)sti * 1024 + pnl * 256 + bj * 128 + wc * 32 + 8 * (fq & 2)) = o;
                }
            }
    }
};
struct MoeOrder {
    const int* tile_e; int ntiles, npn, G, c; int lim;
    __device__ __forceinline__ bool next(int i, Unit& u) const {
        const int L = i * G + c; if (L >= lim) return false;
        const int tile = L / npn, pn = L - tile * npn; u.pm = tile; u.pn = tile_e[tile] * npn + pn; return true;
    }
    __device__ __forceinline__ void a_ready(const Unit&) const {}
    __device__ __forceinline__ void done(const Unit&) const {}
};
struct LateOrder {
    const int* tile_e; int ntiles, G, c, nlate, tile0; unsigned* cnt; unsigned* tmo;
    __device__ __forceinline__ bool next(int i, Unit& u) const {
        const int NL = G - nlate; int L;
        if (c < nlate) L = 2 * NL + i * G + c; else L = (i < 2) ? i * NL + (c - nlate) : 2 * NL + (i - 2) * G + c;
        if (L >= ntiles * 4) return false;
        const int tile = L >> 2, pn = L & 3; u.pm = tile; u.pn = tile_e[tile] * 4 + pn; return true;
    }
    __device__ __forceinline__ void a_ready(const Unit& u) const {
        if (u.pm < tile0) return;
        if (__builtin_amdgcn_readfirstlane((int)threadIdx.x >> 6) == 0) {
            unsigned* w = cnt + 64 * (u.pm - tile0); unsigned sp = 0u;
            while ((unsigned)__builtin_amdgcn_readfirstlane((int)__hip_atomic_load(w, __ATOMIC_RELAXED, __HIP_MEMORY_SCOPE_AGENT)) < 2u) {
                __builtin_amdgcn_s_sleep(2);
                if (++sp > (1u << 22)) { if ((threadIdx.x & 63) == 0) __hip_atomic_store(tmo, 1u, __ATOMIC_RELAXED, __HIP_MEMORY_SCOPE_AGENT); break; }
            }
            __builtin_amdgcn_fence(__ATOMIC_ACQUIRE, "agent");
        }
        asm volatile("s_waitcnt vmcnt(0) lgkmcnt(0)" ::: "memory"); __builtin_amdgcn_s_barrier(); asm volatile("" ::: "memory");
    }
    __device__ __forceinline__ void done(const Unit&) const {}
};
}

#ifndef SB_EARLY_EXIT
#define SB_EARLY_EXIT 1
#endif
#ifndef SB_EXIT_R
#define SB_EXIT_R 0x1p-40f
#endif
namespace att {
typedef __attribute__((address_space(3))) unsigned char l8;
typedef short bf16x8 __attribute__((ext_vector_type(8)));
typedef short s16x4 __attribute__((ext_vector_type(4)));
typedef float f32x16 __attribute__((ext_vector_type(16)));
typedef float f32x4 __attribute__((ext_vector_type(4)));
typedef unsigned u32x4 __attribute__((ext_vector_type(4)));
typedef unsigned short bf16_t;
constexpr int SLOT_K = 12288, SLOT_V = 8192;
constexpr int L_K = 0, L_V = 2 * SLOT_K, L_WS = L_V + 2 * SLOT_V, L_FLAG = L_WS + 8 * 256, L_OST = L_FLAG + 256, L_END = L_OST + 8 * 4096;
__device__ __forceinline__ int crow(int r, int hi) { return (r & 3) + 8 * (r >> 2) + 4 * hi; }
__device__ __forceinline__ void glds16(const void* gsrc, unsigned lds_dst) { unsigned keep;
    asm volatile("s_mov_b32 %0, m0\n\ts_mov_b32 m0, %2\n\ts_nop 0\n\tglobal_load_lds_dwordx4 %1, off\n\ts_mov_b32 m0, %0" : "=&s"(keep) : "v"(gsrc), "s"(lds_dst) : "memory"); }
__device__ __forceinline__ void glds16s(const void* sbase, unsigned voff, unsigned lds_dst) { unsigned keep;
    asm volatile("s_mov_b32 %0, m0\n\ts_mov_b32 m0, %3\n\ts_nop 4\n\tglobal_load_lds_dwordx4 %1, %2\n\ts_mov_b32 m0, %0" : "=&s"(keep) : "v"(voff), "s"(sbase), "s"(lds_dst) : "memory"); }
__device__ __forceinline__ unsigned cvtpk(float lo, float hi) { return pg8::cvt_pk_bf16(lo, hi); }
__device__ __forceinline__ s16x4 vtr(const l8* p) { typedef short v4i16_t __attribute__((ext_vector_type(4)));
    return __builtin_bit_cast(s16x4, __builtin_amdgcn_ds_read_tr16_b64_v4i16((__attribute__((address_space(3))) v4i16_t*)p)); }
__device__ __forceinline__ float bf2f(unsigned short b) { return __builtin_bit_cast(float, (unsigned)b << 16); }
#define ATT_WAIT_BAR() asm volatile("s_waitcnt vmcnt(0) lgkmcnt(0)\n\ts_barrier" ::: "memory")

struct Tensors { const bf16_t* Q; int qp, qh;
                 const bf16_t* K; int kp, kh;
                 const bf16_t* KR;
                 const bf16_t* V; int vp, vh;
                 bf16_t* O; int ocol;
                 float* OSS; int ossc; };

constexpr int SBS = 16384, SB_NS = 7, SB_AHEAD = 3, SB_FLAG = SB_NS * SBS, SB_OST = SB_FLAG + 64;
__device__ __forceinline__ void sb_unit(l8* shm, int bh, int qb, const Tensors& P, int& lo) {
    const int tid = threadIdx.x, lane = tid & 63, r32 = lane & 31, hi = lane >> 5; const int wid = __builtin_amdgcn_readfirstlane(tid >> 6);
    const int b = bh >> 3, h = bh & 7; const long rowbase = (long)b * SEQ; const int q0 = qb * 256, a = q0 + 32 * wid, J = q0 >> 6;
    const unsigned lds0 = (unsigned)(uintptr_t)shm;
    __attribute__((address_space(3))) unsigned* flg = (__attribute__((address_space(3))) unsigned*)(shm + SB_FLAG);
    const bf16_t* kbase = P.K + rowbase * P.kp + h * P.kh + wid * 8;
    const bf16_t* vbase = P.V + (rowbase + 16 * (wid & 3)) * P.vp + h * P.vh + (wid >> 2) * 32;
    const unsigned koff = (unsigned)(lane * P.kp * 2), voffl = (unsigned)(((lane >> 2) * P.vp + (lane & 3) * 8) * 2);
#define SB_DMA(t) do { const int sl_ = (t) % SB_NS; \
        glds16s(kbase + (long)(t) * 64 * P.kp, koff, (unsigned)__builtin_amdgcn_readfirstlane(lds0 + sl_ * SBS + wid * 1024)); \
        glds16s(vbase + (long)(t) * 64 * P.vp, voffl, (unsigned)__builtin_amdgcn_readfirstlane(lds0 + sl_ * SBS + 8192 + wid * 1024)); } while (0)
    if (lo < J - 3) lo = 1 << 20;
    { const int tl = (J - (SB_AHEAD - 1) > 0) ? J - (SB_AHEAD - 1) : 0;
      for (int t = (lo - 1 < J + 3 ? lo - 1 : J + 3); t >= tl; --t) SB_DMA(t);
      if (lo > tl) lo = tl; }
    if (lane < 2) flg[lane * 8 + wid] = 0u;
    bf16x8 qr[4];
    { const bf16_t* qw = P.Q + (rowbase + a + r32) * P.qp + h * P.qh + hi * 8;
#pragma unroll
      for (int c2 = 0; c2 < 4; ++c2) qr[c2] = *(const bf16x8*)(qw + c2 * 16); }
    asm volatile("s_waitcnt vmcnt(0)" ::: "memory");
#pragma unroll
    for (int c2 = 0; c2 < 4; ++c2) asm volatile("" : "+v"(qr[c2]));
    f32x16 o0 = {}, o1 = {};
    float R = 1.0f; bool done = false;
    const int vb = ((lane >> 4) & 1) * 32 + (lane & 3) * 8 + (4 * hi + ((lane & 15) >> 2)) * 64;
    int tw = J + (wid >> 1);
    for (int it = 0; it < J + 4; ++it, --tw) {
        ATT_WAIT_BAR();
        if (SB_EARLY_EXIT && it > 0) {
            const __attribute__((address_space(3))) unsigned* f = flg + ((it - 1) & 1) * 8;
            const unsigned all = f[0] & f[1] & f[2] & f[3] & f[4] & f[5] & f[6] & f[7];
            if (__builtin_amdgcn_readfirstlane(all) != 0u) break;
        }
        if (J - it - SB_AHEAD >= 0 && J - it - SB_AHEAD < lo) { SB_DMA(J - it - SB_AHEAD); lo = J - it - SB_AHEAD; }
        if (tw < 0) done = true;
        if (!done) {
            const int sl = tw % SB_NS;
            const l8* ks = shm + sl * SBS + hi * 1024 + r32 * 16;
            f32x16 p0 = {}, p1 = {};
#pragma unroll
            for (int c2 = 0; c2 < 4; ++c2) {
                const bf16x8 k0 = *(const __attribute__((address_space(3))) bf16x8*)(ks + c2 * 2048), k1 = *(const __attribute__((address_space(3))) bf16x8*)(ks + c2 * 2048 + 512);
                p0 = __builtin_amdgcn_mfma_f32_32x32x16_bf16(k0, qr[c2], p0, 0, 0, 0);
                p1 = __builtin_amdgcn_mfma_f32_32x32x16_bf16(k1, qr[c2], p1, 0, 0, 0);
            }
            if (it == 0) {
                const int tqh = a + r32 - 64 * tw - 1 - 4 * hi;
#pragma unroll
                for (int r = 0; r < 16; ++r) { const int kc = (r & 3) + 8 * (r >> 2); if (kc > tqh) p0[r] = -INFINITY; if (kc + 32 > tqh) p1[r] = -INFINITY; }
            }
            unsigned pw[16];
            float bt0[16], bt1[16];
#pragma unroll
            for (int r = 0; r < 16; ++r) {
                const float e0 = __builtin_amdgcn_exp2f(fminf(p0[r], 100.f)), e1 = __builtin_amdgcn_exp2f(fminf(p1[r], 100.f));
                const float i0 = __builtin_amdgcn_rcpf(1.0f + e0), i1 = __builtin_amdgcn_rcpf(1.0f + e1);
                p0[r] = i0; p1[r] = i1; bt0[r] = e0 * i0; bt1[r] = e1 * i1;
            }
            float RE = R;
#pragma unroll
            for (int g = 7; g >= 0; --g) {
                float r0, r1, r2, r3, b0, b1, b2, b3;
                if (g >= 4) { r0 = p1[4 * (g - 4)]; r1 = p1[4 * (g - 4) + 1]; r2 = p1[4 * (g - 4) + 2]; r3 = p1[4 * (g - 4) + 3]; b0 = bt1[4 * (g - 4)]; b1 = bt1[4 * (g - 4) + 1]; b2 = bt1[4 * (g - 4) + 2]; b3 = bt1[4 * (g - 4) + 3]; }
                else { r0 = p0[4 * g]; r1 = p0[4 * g + 1]; r2 = p0[4 * g + 2]; r3 = p0[4 * g + 3]; b0 = bt0[4 * g]; b1 = bt0[4 * g + 1]; b2 = bt0[4 * g + 2]; b3 = bt0[4 * g + 3]; }
                const float w2 = r3, w1 = w2 * r2, w0 = w1 * r1, G = w0 * r0;
                auto sw = __builtin_amdgcn_permlane32_swap(__float_as_uint(G), __float_as_uint(G), false, false);
                const float g0 = __uint_as_float(sw[0]), g1 = __uint_as_float(sw[1]);
                const float Mx = RE * (hi ? 1.0f : g1);
                const float a3 = b3 * Mx, a2 = b2 * w2 * Mx, a1 = b1 * w1 * Mx, a0 = b0 * w0 * Mx;
                pw[2 * g] = cvtpk(a0, a1); pw[2 * g + 1] = cvtpk(a2, a3);
                RE *= g0 * g1;
            }
            R = RE;
            if (SB_EARLY_EXIT) done = __all(R < SB_EXIT_R);
            const l8* vs = shm + sl * SBS + 8192 + vb;
#pragma unroll
            for (int ks2 = 0; ks2 < 4; ++ks2) {
                const bf16x8 pa = __builtin_bit_cast(bf16x8, (u32x4){pw[4 * ks2], pw[4 * ks2 + 1], pw[4 * ks2 + 2], pw[4 * ks2 + 3]});
                { const s16x4 lo_ = vtr(vs + ks2 * 1024), hh = vtr(vs + ks2 * 1024 + 512);
                  o0 = __builtin_amdgcn_mfma_f32_32x32x16_bf16(pa, (bf16x8){lo_[0], lo_[1], lo_[2], lo_[3], hh[0], hh[1], hh[2], hh[3]}, o0, 0, 0, 0); }
                { const s16x4 lo_ = vtr(vs + 4096 + ks2 * 1024), hh = vtr(vs + 4096 + ks2 * 1024 + 512);
                  o1 = __builtin_amdgcn_mfma_f32_32x32x16_bf16(pa, (bf16x8){lo_[0], lo_[1], lo_[2], lo_[3], hh[0], hh[1], hh[2], hh[3]}, o1, 0, 0, 0); }
            }
        }
        if (lane == 0) flg[(it & 1) * 8 + wid] = done ? 1u : 0u;
    }
    int lane_e = lane; asm volatile("" : "+v"(lane_e));
    const int r32e = lane_e & 31, hie = lane_e >> 5;
    { __attribute__((address_space(3))) bf16_t* stg = (__attribute__((address_space(3))) bf16_t*)(shm + SB_OST) + wid * 1024;
      bf16_t* ow = P.O + (rowbase + a) * 1024 + P.ocol + h * 64;
      float sq[2] = {0.f, 0.f};
#pragma unroll
      for (int dh = 0; dh < 2; ++dh) {
#pragma unroll
          for (int r = 0; r < 16; ++r) stg[crow(r, hie) * 32 + r32e] = (bf16_t)(cvtpk(dh ? o1[r] : o0[r], 0.f) & 0xffffu);
          asm volatile("s_waitcnt lgkmcnt(0)" ::: "memory");
#pragma unroll
          for (int i = 0; i < 2; ++i) { const int row = i * 16 + (lane_e >> 2), ch = lane_e & 3;
              const u32x4 v = *(const __attribute__((address_space(3))) u32x4*)(stg + row * 32 + ch * 8);
              *(u32x4*)(ow + (long)row * 1024 + dh * 32 + ch * 8) = v;
#pragma unroll
              for (int e = 0; e < 4; ++e) { const float x0 = __builtin_bit_cast(float, v[e] << 16), x1 = __builtin_bit_cast(float, v[e] & 0xffff0000u); sq[i] += x0 * x0 + x1 * x1; } }
          asm volatile("s_waitcnt lgkmcnt(0)" ::: "memory");
      }
#pragma unroll
      for (int i = 0; i < 2; ++i) { float s_ = sq[i]; s_ += __shfl_xor(s_, 1); s_ += __shfl_xor(s_, 2);
          if ((lane_e & 3) == 0) P.OSS[(rowbase + a + i * 16 + (lane_e >> 2)) * 16 + P.ossc + h] = s_; } }
    ATT_WAIT_BAR();
#undef SB_DMA
}
template <int MODE>
__device__ __forceinline__ void attn_unit(l8* shm, int bh, int qb, const Tensors& P, const bool pre, const bool nxt) {
    constexpr int NC2 = MODE ? 6 : 4;
    const int tid = threadIdx.x, lane = tid & 63, r32 = lane & 31, hi = lane >> 5; const int wid = __builtin_amdgcn_readfirstlane(tid >> 6);
    const int b = bh >> 3, h = bh & 7; const long rowbase = (long)b * SEQ; const int q0 = qb * 512, a = q0 + 64 * wid;
    const unsigned lds0 = (unsigned)(uintptr_t)shm;
    __attribute__((address_space(3))) float* wsf = (__attribute__((address_space(3))) float*)(shm + L_WS) + wid * 64;
    __attribute__((address_space(3))) unsigned* flg = (__attribute__((address_space(3))) unsigned*)(shm + L_FLAG);
    const int NT = (q0 + 512) / 64;
    const bf16_t* kbase = P.K + rowbase * P.kp + h * P.kh + wid * 8;
    const bf16_t* krbase = MODE ? P.KR + rowbase * ROPE + (wid & 3) * 8 : nullptr;
    const bf16_t* vbase = P.V + (rowbase + 16 * (wid & 3)) * P.vp + h * P.vh + (wid >> 2) * 32;
    const unsigned koff = (unsigned)(lane * P.kp * 2), kroff = (unsigned)(lane * ROPE * 2), voffl = (unsigned)(((lane >> 2) * P.vp + (lane & 3) * 8) * 2);
#define ATT_DMA(j, s) do { \
        glds16s(kbase + (long)(j) * 64 * P.kp, koff, (unsigned)__builtin_amdgcn_readfirstlane(lds0 + L_K + (s) * SLOT_K + wid * 1024)); \
        if (MODE && wid < 4) glds16s(krbase + (long)(j) * 64 * ROPE, kroff, (unsigned)__builtin_amdgcn_readfirstlane(lds0 + L_K + (s) * SLOT_K + (8 + wid) * 1024)); \
        glds16s(vbase + (long)(j) * 64 * P.vp, voffl, (unsigned)__builtin_amdgcn_readfirstlane(lds0 + L_V + (s) * SLOT_V + wid * 1024)); } while (0)
    if (!pre) ATT_DMA(NT - 1, 0);
    if (lane < 2) flg[lane * 8 + wid] = 0u;
    bf16x8 qr[2][NC2];
#pragma unroll
    for (int z = 0; z < 2; ++z) { const bf16_t* qw = P.Q + (rowbase + a + 32 * z + r32) * P.qp + h * P.qh + hi * 8;
#pragma unroll
        for (int c2 = 0; c2 < NC2; ++c2) qr[z][c2] = *(const bf16x8*)(qw + c2 * 16); }
    asm volatile("s_waitcnt vmcnt(0)" ::: "memory");
#pragma unroll
    for (int z = 0; z < 2; ++z)
#pragma unroll
        for (int c2 = 0; c2 < NC2; ++c2) asm volatile("" : "+v"(qr[z][c2]));
    f32x16 o0[2] = {{}, {}}, o1[2] = {{}, {}};
    float m_run[2] = {-1e30f, -1e30f}, l_run[2] = {0.f, 0.f}, R[2] = {1.0f, 1.0f}; bool done = false;
    const int vb = ((lane >> 4) & 1) * 32 + (lane & 3) * 8 + (4 * hi + ((lane & 15) >> 2)) * 64;
    for (int it = 0; it < NT; ++it) {
        const int j = NT - 1 - it, s = it & 1;
        ATT_WAIT_BAR();
        if (MODE == 0 && SB_EARLY_EXIT && it > 0) {
            const __attribute__((address_space(3))) unsigned* f = flg + ((it - 1) & 1) * 8;
            unsigned all = f[0] & f[1] & f[2] & f[3] & f[4] & f[5] & f[6] & f[7];
            if (__builtin_amdgcn_readfirstlane(all) != 0u) { if (nxt) ATT_DMA(NT - 9, 0); break; }
        }
        if (it + 1 < NT) ATT_DMA(j - 1, s ^ 1); else if (nxt) ATT_DMA(NT - 9, 0);
        if (64 * j <= a && !done) {
            const l8* ks = shm + L_K + s * SLOT_K + hi * 1024 + r32 * 16;
            f32x16 p0[2] = {{}, {}}, p1[2] = {{}, {}};
#pragma unroll
            for (int c2 = 0; c2 < NC2; ++c2) {
                const bf16x8 k0 = *(const __attribute__((address_space(3))) bf16x8*)(ks + c2 * 2048), k1 = *(const __attribute__((address_space(3))) bf16x8*)(ks + c2 * 2048 + 512);
#pragma unroll
                for (int z = 0; z < 2; ++z) { p0[z] = __builtin_amdgcn_mfma_f32_32x32x16_bf16(k0, qr[z][c2], p0[z], 0, 0, 0); p1[z] = __builtin_amdgcn_mfma_f32_32x32x16_bf16(k1, qr[z][c2], p1[z], 0, 0, 0); }
            }
            if (64 * j == a) {
#pragma unroll
                for (int z = 0; z < 2; ++z) { const int tqh = 32 * z + r32 - (MODE ? 0 : 1) - 4 * hi;
#pragma unroll
                    for (int r = 0; r < 16; ++r) { const int kc = (r & 3) + 8 * (r >> 2); if (kc > tqh) p0[z][r] = -INFINITY; if (kc + 32 > tqh) p1[z][r] = -INFINITY; } }
            }
            unsigned pw[2][16];
#pragma unroll
            for (int z = 0; z < 2; ++z) {
              if (MODE == 1) {
                float rm = fmaxf(p0[z][0], p1[z][0]);
#pragma unroll
                for (int r = 1; r < 16; ++r) rm = fmaxf(fmaxf(rm, p0[z][r]), p1[z][r]);
                { auto rr = __builtin_amdgcn_permlane32_swap(__float_as_uint(rm), __float_as_uint(rm), false, false); rm = fmaxf(__uint_as_float(rr[0]), __uint_as_float(rr[1])); }
                if (__any(rm > m_run[z] + 8.0f)) {
                    const float mn = fmaxf(m_run[z], rm), alpha = __builtin_amdgcn_exp2f(m_run[z] - mn); m_run[z] = mn; l_run[z] *= alpha;
                    if (hi == 0) wsf[32 * z + r32] = alpha;
#pragma unroll
                    for (int g = 0; g < 4; ++g) { const f32x4 al = *(const __attribute__((address_space(3))) f32x4*)(wsf + 32 * z + 8 * g + 4 * hi);
#pragma unroll
                        for (int i = 0; i < 4; ++i) { o0[z][4 * g + i] *= al[i]; o1[z][4 * g + i] *= al[i]; } }
                }
                float ls = 0.f;
#pragma unroll
                for (int r = 0; r < 16; ++r) { p0[z][r] = __builtin_amdgcn_exp2f(p0[z][r] - m_run[z]); p1[z][r] = __builtin_amdgcn_exp2f(p1[z][r] - m_run[z]); ls += p0[z][r] + p1[z][r]; }
                l_run[z] += ls;
#pragma unroll
                for (int r = 0; r < 8; ++r) { pw[z][r] = cvtpk(p0[z][2 * r], p0[z][2 * r + 1]); pw[z][8 + r] = cvtpk(p1[z][2 * r], p1[z][2 * r + 1]); }
              } else {
                float bt0[16], bt1[16];
#pragma unroll
                for (int r = 0; r < 16; ++r) {
                    const float e0 = __builtin_amdgcn_exp2f(fminf(p0[z][r], 100.f)), e1 = __builtin_amdgcn_exp2f(fminf(p1[z][r], 100.f));
                    const float i0 = __builtin_amdgcn_rcpf(1.0f + e0), i1 = __builtin_amdgcn_rcpf(1.0f + e1);
                    p0[z][r] = i0; p1[z][r] = i1; bt0[r] = e0 * i0; bt1[r] = e1 * i1;
                }
                float RE = R[z];
#pragma unroll
                for (int g = 7; g >= 0; --g) {
                    float r0, r1, r2, r3, b0, b1, b2, b3;
                    if (g >= 4) { r0 = p1[z][4 * (g - 4)]; r1 = p1[z][4 * (g - 4) + 1]; r2 = p1[z][4 * (g - 4) + 2]; r3 = p1[z][4 * (g - 4) + 3]; b0 = bt1[4 * (g - 4)]; b1 = bt1[4 * (g - 4) + 1]; b2 = bt1[4 * (g - 4) + 2]; b3 = bt1[4 * (g - 4) + 3]; }
                    else { r0 = p0[z][4 * g]; r1 = p0[z][4 * g + 1]; r2 = p0[z][4 * g + 2]; r3 = p0[z][4 * g + 3]; b0 = bt0[4 * g]; b1 = bt0[4 * g + 1]; b2 = bt0[4 * g + 2]; b3 = bt0[4 * g + 3]; }
                    const float w2 = r3, w1 = w2 * r2, w0 = w1 * r1, G = w0 * r0;
                    auto sw = __builtin_amdgcn_permlane32_swap(__float_as_uint(G), __float_as_uint(G), false, false);
                    const float g0 = __uint_as_float(sw[0]), g1 = __uint_as_float(sw[1]);
                    const float Mx = RE * (hi ? 1.0f : g1);
                    const float a3 = b3 * Mx, a2 = b2 * w2 * Mx, a1 = b1 * w1 * Mx, a0 = b0 * w0 * Mx;
                    pw[z][2 * g] = cvtpk(a0, a1); pw[z][2 * g + 1] = cvtpk(a2, a3);
                    RE *= g0 * g1;
                }
                R[z] = RE;
              }
            }
            if (MODE == 0 && SB_EARLY_EXIT) done = __all(fmaxf(R[0], R[1]) < SB_EXIT_R);
            const l8* vs = shm + L_V + s * SLOT_V + vb;
#pragma unroll
            for (int ks2 = 0; ks2 < 4; ++ks2) {
                bf16x8 vf0, vf1;
                { const s16x4 lo = vtr(vs + ks2 * 1024), hh = vtr(vs + ks2 * 1024 + 512); vf0 = (bf16x8){lo[0], lo[1], lo[2], lo[3], hh[0], hh[1], hh[2], hh[3]}; }
                { const s16x4 lo = vtr(vs + 4096 + ks2 * 1024), hh = vtr(vs + 4096 + ks2 * 1024 + 512); vf1 = (bf16x8){lo[0], lo[1], lo[2], lo[3], hh[0], hh[1], hh[2], hh[3]}; }
#pragma unroll
                for (int z = 0; z < 2; ++z) {
                    const bf16x8 pa = __builtin_bit_cast(bf16x8, (u32x4){pw[z][4 * ks2], pw[z][4 * ks2 + 1], pw[z][4 * ks2 + 2], pw[z][4 * ks2 + 3]});
                    o0[z] = __builtin_amdgcn_mfma_f32_32x32x16_bf16(pa, vf0, o0[z], 0, 0, 0);
                    o1[z] = __builtin_amdgcn_mfma_f32_32x32x16_bf16(pa, vf1, o1[z], 0, 0, 0);
                }
            }
        }
        if (MODE == 0 && SB_EARLY_EXIT) { if (lane == 0) flg[s * 8 + wid] = done ? 1u : 0u; }
    }
    int lane_e = lane; asm volatile("" : "+v"(lane_e));
    const int r32e = lane_e & 31, hie = lane_e >> 5;
#pragma unroll
    for (int z = 0; z < 2; ++z) {
        if (MODE == 1) {
            float l = l_run[z];
            { auto rr = __builtin_amdgcn_permlane32_swap(__float_as_uint(l), __float_as_uint(l), false, false); l = __uint_as_float(rr[0]) + __uint_as_float(rr[1]); }
            if (hie == 0) wsf[r32e] = __builtin_amdgcn_rcpf(l);
#pragma unroll
            for (int g = 0; g < 4; ++g) { const f32x4 il = *(const __attribute__((address_space(3))) f32x4*)(wsf + 8 * g + 4 * hie);
#pragma unroll
                for (int i = 0; i < 4; ++i) { o0[z][4 * g + i] *= il[i]; o1[z][4 * g + i] *= il[i]; } }
        }
        __attribute__((address_space(3))) bf16_t* stg = (__attribute__((address_space(3))) bf16_t*)(shm + L_OST) + wid * 2048;
#pragma unroll
        for (int r = 0; r < 16; ++r) { const int orow = crow(r, hie);
            stg[orow * 64 + r32e] = (bf16_t)(cvtpk(o0[z][r], 0.f) & 0xffffu); stg[orow * 64 + 32 + r32e] = (bf16_t)(cvtpk(o1[z][r], 0.f) & 0xffffu); }
        asm volatile("s_waitcnt lgkmcnt(0)" ::: "memory");
        bf16_t* ow = P.O + (rowbase + a + 32 * z) * 1024 + P.ocol + h * 64;
#pragma unroll
        for (int i = 0; i < 4; ++i) { const int row = i * 8 + (lane_e >> 3), ch = lane_e & 7;
            const u32x4 v = *(const __attribute__((address_space(3))) u32x4*)(stg + row * 64 + ch * 8);
            *(u32x4*)(ow + (long)row * 1024 + ch * 8) = v;
            float sq = 0.f;
#pragma unroll
            for (int e = 0; e < 4; ++e) { const float x0 = __builtin_bit_cast(float, v[e] << 16), x1 = __builtin_bit_cast(float, v[e] & 0xffff0000u); sq += x0 * x0 + x1 * x1; }
            sq += __shfl_xor(sq, 1); sq += __shfl_xor(sq, 2); sq += __shfl_xor(sq, 4);
            if (ch == 0) P.OSS[(rowbase + a + 32 * z + row) * 16 + P.ossc + h] = sq; }
        asm volatile("s_waitcnt lgkmcnt(0)" ::: "memory");
    }
    ATT_WAIT_BAR();
#undef ATT_DMA
}
}

__device__ __forceinline__ float wave_sum(float v) {
#pragma unroll
    for (int o = 1; o < 64; o <<= 1) v += __shfl_xor(v, o);
    return v;
}
__device__ __forceinline__ float bflo(unsigned w) { return __builtin_bit_cast(float, w << 16); }
__device__ __forceinline__ float bfhi(unsigned w) { return __builtin_bit_cast(float, w & 0xffff0000u); }

template <class V> __device__ __forceinline__ void tr_load(const V& val, int nblk, int item, int lane, float (&tv)[32]) {
    const int kb = item / nblk, nb = item - kb * nblk, k0 = 64 * kb, n0 = 32 * nb;
#pragma unroll
    for (int i = 0; i < 32; ++i) tv[i] = val(k0 + 2 * i + (lane >> 5), n0 + (lane & 31));
}
__device__ __forceinline__ void tr_store(const float (&tv)[32], int K, int nblk, bf16* WT, LAS float* scr, int item, int lane) {
    const int kb = item / nblk, nb = item - kb * nblk, k0 = 64 * kb, n0 = 32 * nb;
#pragma unroll
    for (int i = 0; i < 32; ++i) scr[(2 * i + (lane >> 5)) * 33 + (lane & 31)] = tv[i];
    LDS_WAIT(); asm volatile("" ::: "memory");
    const int c = lane & 7;
#pragma unroll
    for (int j = 0; j < 4; ++j) { const int n = (lane >> 3) + 8 * j; const LAS float* s = scr + (8 * c) * 33 + n;
        v4u o; o.x = pk2(s[0 * 33], s[1 * 33]); o.y = pk2(s[2 * 33], s[3 * 33]); o.z = pk2(s[4 * 33], s[5 * 33]); o.w = pk2(s[6 * 33], s[7 * 33]);
        *(GAS v4u*)(WT + (size_t)(n0 + n) * K + k0 + 8 * c) = o; }
    LDS_WAIT(); asm volatile("" ::: "memory");
}
template <class V> __device__ __forceinline__ void tr_load4(const V& val, int nblk, int item, int lane, f32x4 (&tv)[8]) {
    const int kb = item / nblk, nb = item - kb * nblk, k0 = 64 * kb, n0 = 32 * nb;
#pragma unroll
    for (int i = 0; i < 8; ++i) tv[i] = val.v4(k0 + 8 * i + (lane >> 3), n0 + 4 * (lane & 7));
}
__device__ __forceinline__ void tr_store4(const f32x4 (&tv)[8], int K, int nblk, bf16* WT, LAS float* scr, int item, int lane) {
    const int kb = item / nblk, nb = item - kb * nblk, k0 = 64 * kb, n0 = 32 * nb;
#pragma unroll
    for (int i = 0; i < 8; ++i) { LAS float* d = scr + (8 * i + (lane >> 3)) * 33 + 4 * (lane & 7); d[0] = tv[i].x; d[1] = tv[i].y; d[2] = tv[i].z; d[3] = tv[i].w; }
    LDS_WAIT(); asm volatile("" ::: "memory");
    const int c = lane & 7;
#pragma unroll
    for (int j = 0; j < 4; ++j) { const int n = (lane >> 3) + 8 * j; const LAS float* s = scr + (8 * c) * 33 + n;
        v4u o; o.x = pk2(s[0 * 33], s[1 * 33]); o.y = pk2(s[2 * 33], s[3 * 33]); o.z = pk2(s[4 * 33], s[5 * 33]); o.w = pk2(s[6 * 33], s[7 * 33]);
        *(GAS v4u*)(WT + (size_t)(n0 + n) * K + k0 + 8 * c) = o; }
    LDS_WAIT(); asm volatile("" ::: "memory");
}
struct XwSrc { uintptr_t wg; long long dlt  ; uintptr_t wd, g, WGU, WD; };
constexpr int XW_GU1 = 16 * 16, XW_GU = NEXP * XW_GU1, XW_D1 = 4 * 32, XW_D = NEXP * XW_D1, XW_NI = XW_GU + XW_D;
__device__ __forceinline__ void xw_load(const XwSrc& S, int r, int lane, f32x4 (&tv)[8], float (&gk)[8]) {
    const bool gu = r < XW_GU; const int rr = gu ? r : r - XW_GU; const int e = gu ? (rr >> 8) : (rr >> 7); const int li = gu ? (rr & 255) : (rr & 127);
    const int kb = gu ? (li >> 4) : (li >> 5), nb = gu ? (li & 15) : (li & 31); const int k = 64 * kb + (lane >> 3), n = 32 * nb + 4 * (lane & 7);
    const uintptr_t bgu = S.wg + (uintptr_t)(((n >> 2) & 1) * S.dlt), base = (gu ? bgu : S.wd) + (uintptr_t)e * (DM * DEXP * 4);
    const int pitch = gu ? DEXP : DM; const int col = gu ? 4 * (n >> 3) : n;
    const GAS float* p = (const GAS float*)base + (size_t)k * pitch + col; const GAS float* gp = (const GAS float*)S.g + (gu ? k : (lane >> 3));
#pragma unroll
    for (int i = 0; i < 8; ++i) { tv[i] = *(const GAS f32x4*)(p + (size_t)(8 * i) * pitch); gk[i] = gp[8 * i]; }
}
__device__ __forceinline__ void xw_store(const XwSrc& S, int r, int lane, LAS float* scr, const f32x4 (&tv)[8], const float (&gk)[8]) {
    const bool gu = r < XW_GU; const int rr = gu ? r : r - XW_GU; const int e = gu ? (rr >> 8) : (rr >> 7); const int li = gu ? (rr & 255) : (rr & 127);
    const int kb = gu ? (li >> 4) : (li >> 5), nb = gu ? (li & 15) : (li & 31); const int k0 = 64 * kb, n0 = 32 * nb; const int K = gu ? DM : DEXP;
    bf16* WT = (bf16*)((gu ? S.WGU : S.WD) + (uintptr_t)e * (gu ? 512 * 1024 * 2 : 1024 * 256 * 2));
#pragma unroll
    for (int i = 0; i < 8; ++i) { const float gm = gu ? gk[i] : 1.0f; LAS float* d = scr + (8 * i + (lane >> 3)) * 33 + 4 * (lane & 7); d[0] = tv[i].x * gm; d[1] = tv[i].y * gm; d[2] = tv[i].z * gm; d[3] = tv[i].w * gm; }
    LDS_WAIT(); asm volatile("" ::: "memory");
    const int c = lane & 7;
#pragma unroll
    for (int j = 0; j < 4; ++j) { const int n = (lane >> 3) + 8 * j; const LAS float* s = scr + (8 * c) * 33 + n;
        v4u o; o.x = pk2(s[0 * 33], s[1 * 33]); o.y = pk2(s[2 * 33], s[3 * 33]); o.z = pk2(s[4 * 33], s[5 * 33]); o.w = pk2(s[6 * 33], s[7 * 33]);
        *(GAS v4u*)(WT + (size_t)(n0 + n) * K + k0 + 8 * c) = o; }
    LDS_WAIT(); asm volatile("" ::: "memory");
}
template <class V> __device__ __forceinline__ void tr_item(const V& val, int K, int nblk, bf16* WT, LAS float* scr, int item, int lane) {
    float tv[32]; tr_load(val, nblk, item, lane, tv); tr_store(tv, K, nblk, WT, scr, item, lane);
}
struct VWin { const float* w; __device__ __forceinline__ float operator()(int k, int n) const {
    if (n >= INC) return 0.f; const int i = n - 1920; const int src = (i < 0) ? n : 1920 + (i >> 1) + 16 * (i & 1); return w[(size_t)k * INC + src]; } };
struct VWuq { const float* w; const float* g; __device__ __forceinline__ float operator()(int k, int n) const {
    const int h = n / QKD, j = n - h * QKD, i = j - NOPE; const int src = (i < 0) ? n : h * QKD + NOPE + (i >> 1) + 16 * (i & 1); return w[(size_t)k * 768 + src] * g[k]; } };
struct VWukv { const float* w; const float* g; __device__ __forceinline__ float operator()(int k, int n) const { return k < KVLORA ? w[(size_t)k * 1024 + n] * g[k] : 0.f; } };
struct VWout { const float* w; const float* gs; const float* gm; __device__ __forceinline__ float operator()(int k, int n) const { return w[(size_t)k * 1024 + n] * (k < SBW ? gs[k] : gm[k - SBW]); } };
struct VWr { const float* wg; const float* we; const float* g; __device__ __forceinline__ float operator()(int k, int n) const {
    if (n < NGRP) return wg[(size_t)k * NGRP + n] * g[k]; if (n >= 128 && n < 128 + NEXP) return we[(size_t)k * NEXP + (n - 128)] * g[k]; return 0.f; } };
struct VWgu { const float* wgt; long long dlt  ; const float* g; __device__ __forceinline__ float operator()(int k, int n) const {
    const int hc = 4 * (n >> 3) + (n & 3); const float* w = (const float*)((uintptr_t)wgt + (uintptr_t)(((n >> 2) & 1) * dlt)); return w[(size_t)k * DEXP + hc] * g[k]; }
    __device__ __forceinline__ f32x4 v4(int k, int n) const {
        const float* w = (const float*)((uintptr_t)wgt + (uintptr_t)(((n >> 2) & 1) * dlt)); return *(const GAS f32x4*)(w + (size_t)k * DEXP + 4 * (n >> 3)) * g[k]; } };
struct VWd { const float* w; __device__ __forceinline__ float operator()(int k, int n) const { return w[(size_t)k * DM + n]; }
    __device__ __forceinline__ f32x4 v4(int k, int n) const { return *(const GAS f32x4*)(w + (size_t)k * DM + n); } };

struct Args { const void* in[20]; float* out; unsigned char* ws; int ph_lo, ph_hi, pad0, pad1; };
constexpr int NPHASE = 12;
__global__ void __launch_bounds__(NWAVES * 64, 2) fwd_kernel(Args args) {
    extern __shared__ __attribute__((aligned(16))) unsigned char lds_raw[];
    LAS unsigned char* lds = (LAS unsigned char*)lds_raw;
    volatile LAS unsigned* MISC = (volatile LAS unsigned*)(lds + MISC_OFF);
    const int tid = threadIdx.x, lane = tid & 63, wave = __builtin_amdgcn_readfirstlane(tid >> 6);
    const int G = gridDim.x, bx = blockIdx.x;
    const __attribute__((address_space(4))) Args* KA = (const __attribute__((address_space(4))) Args*)__builtin_amdgcn_kernarg_segment_ptr();
#define FIN(i) ((const float*)KA->in[i])
#define WSP(TY, off) ((TY*)(KA->ws + (off)))
    gu32* ctl = (gu32*)WSP(unsigned char, WS_CTL);
    for (int u = tid; u < (LDS_BYTES - LDSCTL_OFF) / 4; u += NWAVES * 64) ((LAS unsigned*)(lds + LDSCTL_OFF))[u] = 0u;
    __syncthreads();
    const int lo = KA->ph_lo, hi = KA->ph_hi;
    const bool use_bar = (hi - lo) > 1;
    XcdBarrier bar; bar.bar = (unsigned*)(ctl + CW_BAR); bar.x = 0; bar.st = nullptr;
    if (use_bar) bar = xcd_barrier_post((unsigned*)(ctl + CW_BAR), MISC + 8);
#ifndef PH_MASK
#define PH_MASK 0xfff
#endif
#define IN(k) ((((PH_MASK) >> (k)) & 1) && lo <= (k) && (k) < hi)
#ifndef PROBE_PHASE
#define PROBE_PHASE -1
#endif
#ifndef ATT_SEL
#define ATT_SEL 3
#endif
#define REP(k) for (int rep_ = 0; rep_ < ((PROBE_PHASE) == (k) ? 2 : 1); ++rep_)
#define SEAM(k) do { if (IN(k) && IN((k) + 1)) xcd_barrier(bar); } while (0)
    const int gw = bx * NWAVES + wave, NGW = G * NWAVES;

    if (IN(0)) REP(0) {
        LAS float* scr = (LAS float*)(lds + RING_OFF + wave * 16384);
        constexpr int I_WIN = 16 * 64, I_WUQ = 4 * 24, I_WUKV = 2 * 32, I_WOUT = 16 * 32, I_WR = 16 * 8;
        constexpr int NITEMS = I_WIN + I_WUQ + I_WUKV + I_WOUT + I_WR;
        for (int it = gw; it < NITEMS; it += NGW) {
            int r = it;
            if (r < I_WIN) { tr_item(VWin{FIN(3)}, 1024, 64, WSP(bf16, WS_WIN), scr, r, lane); continue; } r -= I_WIN;
            if (r < I_WUQ) { tr_item(VWuq{FIN(5), FIN(4)}, 256, 24, WSP(bf16, WS_WUQ), scr, r, lane); continue; } r -= I_WUQ;
            if (r < I_WUKV) { tr_item(VWukv{FIN(7), FIN(6)}, 128, 32, WSP(bf16, WS_WUKV), scr, r, lane); continue; } r -= I_WUKV;
            if (r < I_WOUT) { tr_item(VWout{FIN(10), FIN(8), FIN(9)}, 1024, 32, WSP(bf16, WS_WOUT), scr, r, lane); continue; } r -= I_WOUT;
            tr_item(VWr{FIN(12), FIN(14), FIN(11)}, 1024, 8, WSP(bf16, WS_WR), scr, r, lane);
        }
        { const float* x = FIN(0); bf16* H = WSP(bf16, WS_H); float* INV1 = WSP(float, WS_INV1); f32x4 gn[4];
#pragma unroll
          for (int j = 0; j < 4; ++j) gn[j] = *((const GAS f32x4*)FIN(2) + lane + 64 * j);
          for (int m = gw; m < T; m += 4 * NGW) {
              f32x4 v[4][4]; float s2[4];
#pragma unroll
              for (int r = 0; r < 4; ++r) { const GAS f32x4* xr = (const GAS f32x4*)(x + (size_t)(m + r * NGW) * DM) + lane;
#pragma unroll
                  for (int j = 0; j < 4; ++j) v[r][j] = xr[64 * j]; }
#pragma unroll
              for (int r = 0; r < 4; ++r) { float s = 0.f;
#pragma unroll
                  for (int j = 0; j < 4; ++j) s += (v[r][j].x * v[r][j].x + v[r][j].y * v[r][j].y) + (v[r][j].z * v[r][j].z + v[r][j].w * v[r][j].w);
                  s2[r] = s; }
#pragma unroll
              for (int o = 1; o < 64; o <<= 1) {
#pragma unroll
                  for (int r = 0; r < 4; ++r) s2[r] += __shfl_xor(s2[r], o); }
#pragma unroll
              for (int r = 0; r < 4; ++r) { const float var = s2[r] * (1.f / DM) + EPS; const float rstd = rsqrtf(var); if (lane == 0) INV1[m + r * NGW] = sqrtf(var);
                  GAS unsigned long long* o8 = (GAS unsigned long long*)(H + (size_t)(m + r * NGW) * DM) + lane;
#pragma unroll
                  for (int j = 0; j < 4; ++j) { const f32x4 y = v[r][j] * rstd * gn[j]; o8[64 * j] = (unsigned long long)pg8::cvt_pk_bf16(y.x, y.y) | ((unsigned long long)pg8::cvt_pk_bf16(y.z, y.w) << 32); } }
          } }
        { const int* positions = (const int*)KA->in[1]; unsigned* TAB = WSP(unsigned, WS_TAB);
          for (int idx = bx * (NWAVES * 64) + tid; idx < T * 16; idx += G * NWAVES * 64) {
            const int tok = idx >> 4, i = idx & 15;
            const double invd = ((i & 1) ? 0.56234132519034908039 : 1.0) * ((i & 2) ? 0.31622776601683793320 : 1.0) * ((i & 4) ? 0.1 : 1.0) * ((i & 8) ? 0.01 : 1.0);
            const double ang = (double)positions[tok] * invd;
            const double kq = rint(ang * 0.63661977236758134308);
            const double rr = fma(-kq, 1.57079632679489661923, ang) - kq * 6.123233995736766e-17;
            const float r = (float)rr, r2 = r * r;
            const float sn = r + r * r2 * (-1.6666667163e-01f + r2 * (8.3333337680e-03f + r2 * (-1.9841270114e-04f + r2 * 2.7557314297e-06f)));
            const float cs = 1.0f + r2 * (-0.5f + r2 * (4.1666667908e-02f + r2 * (-1.3888889225e-03f + r2 * (2.4801587642e-05f + r2 * -2.7557314297e-07f))));
            const int q = (int)((long long)kq & 3);
            const float c = (q == 0) ? cs : (q == 1) ? -sn : (q == 2) ? -cs : sn;
            const float s = (q == 0) ? sn : (q == 1) ? cs : (q == 2) ? -sn : -cs;
            TAB[idx] = pk2(c, s);
          } }
    }
    SEAM(0);
    if (IN(1)) REP(1) {
        pg8::Gemm g{WSP(bf16, WS_H), WSP(bf16, WS_WIN), T, INP, DM, nullptr}; pg8::StaticOrder S; S.init(T, INP, G, bx);
        epi::EpiProj E{WSP(bf16, WS_QS), WSP(bf16, WS_CQ), WSP(bf16, WS_CKV), WSP(bf16, WS_KROPE), WSP(float, WS_SSQQ), WSP(float, WS_SSQKV), WSP(unsigned, WS_TAB)};
        pg8::gemm_phase<epi::EpiProj, pg8::StaticOrder, true, false>(lds + RING_OFF, g, S, E);
    }
    SEAM(1);
    if (IN(2)) REP(2) {
#ifndef P2SEL
#define P2SEL 3
#endif
        if (P2SEL & 1) { pg8::Gemm g{WSP(bf16, WS_CQ), WSP(bf16, WS_WUQ), T, 768, 256, nullptr}; pg8::StaticOrder S; S.init(T, 768, G, bx);
          epi::EpiQup E{WSP(bf16, WS_QM), WSP(float, WS_SSQQ), WSP(unsigned, WS_TAB)};
          pg8::gemm_phase<epi::EpiQup, pg8::StaticOrder, true, false>(lds + RING_OFF, g, S, E); }
        if (P2SEL & 2) { pg8::Gemm g{WSP(bf16, WS_CKV), WSP(bf16, WS_WUKV), T, 1024, 128, nullptr};   pg8::StaticOrder S; S.init(T, 1024, G, bx);
          epi::EpiKVup E{WSP(bf16, WS_KVM), WSP(float, WS_SSQKV)};
          pg8::gemm_phase<epi::EpiKVup, pg8::StaticOrder, true, false>(lds + RING_OFF, g, S, E); }
    }
    SEAM(2);
    if (IN(3)) {
        { const att::Tensors TS{WSP(bf16, WS_QS), 512, 64, WSP(bf16, WS_KS), 512, 64, nullptr, WSP(bf16, WS_VS), 512, 64, WSP(bf16, WS_O), 0, WSP(float, WS_OSS), 0};
#ifndef XW_REPS
#define XW_REPS 1
#endif
          const int xw_at = 7 - ((bx >> 3) & 7);
          for (int u = bx; u < BATCH * NH; u += G)
              if (ATT_SEL & 1) REP(30) { int lo = 1 << 20; for (int qb = 7; qb >= 0; --qb) {
                  if (qb == xw_at && u == bx) {
                      LAS float* scr = (LAS float*)(lds + RING_OFF + 4096 + wave * 16384);
                      for (int xrep_ = 0; xrep_ < XW_REPS; ++xrep_)
                      { int lane_x = threadIdx.x & 63; asm volatile("" : "+v"(lane_x));
#define lane lane_x
                      { const XwSrc XS{(uintptr_t)FIN(16), (long long)((uintptr_t)FIN(17) - (uintptr_t)FIN(16)), (uintptr_t)FIN(18), (uintptr_t)FIN(11), (uintptr_t)WSP(bf16, WS_WGU), (uintptr_t)WSP(bf16, WS_WD)};
                        f32x4 a0[8], b0[8], c0[8], d0[8]; float ag[8], bg[8], cg[8], dg[8];
#define XI(n) ((base + (n) * NGW) < XW_NI ? (base + (n) * NGW) : XW_NI - 1)
                        for (int base = gw; base < XW_NI; base += 6 * NGW) {
                            xw_load(XS, XI(0), lane, a0, ag); xw_load(XS, XI(1), lane, b0, bg); xw_load(XS, XI(2), lane, c0, cg);
                            xw_load(XS, XI(3), lane, d0, dg); xw_store(XS, XI(0), lane, scr, a0, ag);
                            xw_load(XS, XI(4), lane, a0, ag); xw_store(XS, XI(1), lane, scr, b0, bg);
                            xw_load(XS, XI(5), lane, b0, bg); xw_store(XS, XI(2), lane, scr, c0, cg);
                            xw_store(XS, XI(3), lane, scr, d0, dg); xw_store(XS, XI(4), lane, scr, a0, ag); xw_store(XS, XI(5), lane, scr, b0, bg);
                        } }
#undef XI
#undef lane
                      }
                      lo = 1 << 20; __syncthreads();
                  }
                  att::sb_unit(lds + RING_OFF, u, qb, TS, lo); } } }
        { bf16* KVM = WSP(bf16, WS_KVM);
          const att::Tensors TM{WSP(bf16, WS_QM), 768, 96, KVM, 1024, 128, WSP(bf16, WS_KROPE), KVM + 64, 1024, 128, WSP(bf16, WS_O), 512, WSP(float, WS_OSS), 8};
          for (int u = bx; u < BATCH * NH; u += G)
              if (ATT_SEL & 2) REP(31) for (int qb = 3; qb >= 0; --qb) att::attn_unit<1>(lds + RING_OFF, u, qb, TM, qb != 3, qb != 0); }
    }
    SEAM(3);
    if (IN(5)) REP(5) {
        pg8::Gemm g{WSP(bf16, WS_O), WSP(bf16, WS_WOUT), T, DM, DM, nullptr}; pg8::StaticOrder S; S.init(T, DM, G, bx);
        epi::EpiX1 E{WSP(bf16, WS_H), FIN(2), WSP(bf16, WS_X1B), WSP(float, WS_SSQ2), WSP(float, WS_OSS), WSP(float, WS_INV1), (LAS float*)(lds + LDSCTL_OFF + 1024)};
        pg8::gemm_phase<epi::EpiX1, pg8::StaticOrder, true, false>(lds + RING_OFF, g, S, E);
    }
    SEAM(5);
    if (IN(6)) REP(6) {
        pg8::Gemm g{WSP(bf16, WS_X1B), WSP(bf16, WS_WR), T, 256, DM, nullptr}; pg8::StaticOrder S; S.init(T, 256, G, bx);
        LAS int* ebuf = (LAS int*)(lds + LDSCTL_OFF + 1024); LAS int* wcnt = (LAS int*)(lds + LDSCTL_OFF + 1024 + 2048);
        int* EIDX = WSP(int, WS_EIDX); int* RANK = WSP(int, WS_RANK); int* CNT = WSP(int, WS_CNT);
        epi::EpiRouter E{WSP(float, WS_SSQ2), WSP(float, WS_RSTD2), FIN(13), FIN(15), EIDX, WSP(float, WS_EW), ebuf};
        pg8::Unit u;
        for (int i = 0; S.next(i, u); ++i) {
            epi::OneUnit S1{u};
            pg8::gemm_phase<epi::EpiRouter, epi::OneUnit, true, false>(lds + RING_OFF, g, S1, E);
            __syncthreads();
            const int ch = u.pm; int tq = tid; asm volatile("" : "+v"(tq));
            int e0 = -1, e1 = -1;
            if (tq < 256) { e0 = ebuf[tq * 2]; e1 = ebuf[tq * 2 + 1]; }
            int rk0 = 0, rk1 = 0;
            const unsigned long long ltm = (1ull << lane) - 1ull;
            for (int e = 0; e < NEXP; ++e) {
                const unsigned long long k0 = __ballot(e0 == e), k1 = __ballot(e1 == e);
                if (e0 == e) rk0 = __popcll(k0 & ltm);
                if (e1 == e) rk1 = __popcll(k1 & ltm);
                if (lane == 0 && wave < 4) { wcnt[(wave * 2 + 0) * 32 + e] = __popcll(k0); wcnt[(wave * 2 + 1) * 32 + e] = __popcll(k1); }
            }
            __syncthreads();
            if (tq < 256) {
                int b0 = 0, b1 = 0;
                for (int sg = 0; sg < wave * 2; ++sg) { b0 += wcnt[sg * 32 + e0]; b1 += wcnt[sg * 32 + e1]; }
                b1 += wcnt[(wave * 2) * 32 + e1];
                const int tok = ch * 256 + tq; RANK[tok * 2] = b0 + rk0; RANK[tok * 2 + 1] = b1 + rk1;
            }
            if (tq < 32) { int sm = 0; for (int sg = 0; sg < 8; ++sg) sm += wcnt[sg * 32 + tq]; CNT[ch * 32 + tq] = sm; }
            __syncthreads();
        }
    }
    SEAM(6);
    if (IN(8)) REP(8) {
        int tq = tid; asm volatile("" : "+v"(tq));
        LAS int* tot = (LAS int*)(lds + RING_OFF); LAS int* pbase = tot + 32; LAS int* mybase = tot + 72;
        const int* EIDX = WSP(int, WS_EIDX); const float* EW = WSP(float, WS_EW); const int* RANK = WSP(int, WS_RANK); const int* CNT = WSP(int, WS_CNT);
        int* TILEE = WSP(int, WS_TILEE); int* SLOTTOK = WSP(int, WS_SLOTTOK); float* SLOTW = WSP(float, WS_SLOTW); float* SLOTRS = WSP(float, WS_SLOTRS); const float* RSTD2 = WSP(float, WS_RSTD2);
        for (int ch = bx; ch < T / 256; ch += G) {
            { LAS int* part = tot + 128;
              const int e = tq & 31, cg = tq >> 5; int t = 0, mb = 0;
#pragma unroll
              for (int i = 0; i < 16; ++i) { const int c = cg * 16 + i; const int v = CNT[c * 32 + e]; t += v; mb += (c < ch) ? v : 0; }
              part[(cg * 2 + 0) * 32 + e] = t; part[(cg * 2 + 1) * 32 + e] = mb;
              __syncthreads();
              if (tq < 32) { int ts = 0, ms = 0;
#pragma unroll
                  for (int g = 0; g < 16; ++g) { ts += part[(g * 2 + 0) * 32 + tq]; ms += part[(g * 2 + 1) * 32 + tq]; }
                  tot[tq] = ts; mybase[tq] = ms; } }
            __syncthreads();
            if (tq == 0) { int pb = 0; for (int e = 0; e < NEXP; ++e) { pbase[e] = pb; pb += ((tot[e] + 255) >> 8) << 8; } pbase[32] = pb; }
            __syncthreads();
            if (tq < 256) { const int tok = ch * 256 + tq; const float rs2 = RSTD2[tok];
#pragma unroll
                for (int k = 0; k < 2; ++k) { const int e = EIDX[tok * 2 + k]; const int slot = pbase[e] + mybase[e] + RANK[tok * 2 + k]; SLOTTOK[slot] = tok * 2 + k; SLOTRS[slot] = rs2; SLOTW[slot] = EW[tok * 2 + k]; } }
            if (ch < NEXP) { const int e = ch; const int endp = pbase[e] + (((tot[e] + 255) >> 8) << 8);
                for (int s = pbase[e] + tot[e] + tq; s < endp; s += NWAVES * 64) { SLOTTOK[s] = -1; SLOTW[s] = 0.f; SLOTRS[s] = 0.f; } }
            if (ch == 0) { if (tq < 32) { const int nte = (tot[tq] + 255) >> 8; for (int tl = 0; tl < nte; ++tl) TILEE[(pbase[tq] >> 8) + tl] = tq; }
                           if (tq == 0) TILEE[MAXTILES] = pbase[32] >> 8; }
            __syncthreads();
        }
    }
    SEAM(8);
    if (IN(9)) REP(9) {
        const int* TILEE = WSP(int, WS_TILEE); const int* SLOTTOK = WSP(int, WS_SLOTTOK);
        const int ntiles = TILEE[MAXTILES]; const int n6 = ntiles * 2, full = (n6 / G) * G;
        pg8::Gemm g{WSP(bf16, WS_X1B), WSP(bf16, WS_WGU), T, 512, DM, SLOTTOK}; epi::MoeOrder S{TILEE, ntiles, 2, G, bx, full};
        epi::EpiGateUp E{WSP(float, WS_SLOTRS), WSP(bf16, WS_HID)};
        pg8::gemm_phase<epi::EpiGateUp, epi::MoeOrder, true, true>(lds + RING_OFF, g, S, E);
    }
    SEAM(9);
    if (IN(10)) REP(10) {
        const int* TILEE = WSP(int, WS_TILEE);
        const int ntiles = TILEE[MAXTILES]; const int n6 = ntiles * 2, full = (n6 / G) * G, nlate = n6 - full, tile0 = full >> 1;
        unsigned* lcnt = (unsigned*)(ctl + CW_LATE);
        if (bx < nlate) {
            const int L6 = full + bx; pg8::Unit u; u.pm = L6 >> 1; u.pn = TILEE[L6 >> 1] * 2 + (L6 & 1);
            pg8::Gemm g{WSP(bf16, WS_X1B), WSP(bf16, WS_WGU), T, 512, DM, WSP(int, WS_SLOTTOK)}; epi::OneUnit S1{u};
            epi::EpiGateUp E{WSP(float, WS_SLOTRS), WSP(bf16, WS_HID)};
            pg8::gemm_phase<epi::EpiGateUp, epi::OneUnit, true, true>(lds + RING_OFF, g, S1, E);
            asm volatile("s_waitcnt vmcnt(0)" ::: "memory"); __syncthreads();
            if (tid == 0) { __builtin_amdgcn_fence(__ATOMIC_RELEASE, "agent"); asm volatile("s_waitcnt vmcnt(0)" ::: "memory");
                __hip_atomic_fetch_add(lcnt + 64 * ((L6 >> 1) - tile0), 1u, __ATOMIC_RELAXED, __HIP_MEMORY_SCOPE_AGENT); }
        }
        pg8::Gemm g{WSP(bf16, WS_HID), WSP(bf16, WS_WD), MAXTILES * 256, 1024, DEXP, nullptr};
        epi::LateOrder S{TILEE, ntiles, G, bx, nlate, tile0, lcnt, (unsigned*)(ctl + CW_LATE_TMO)};
        epi::EpiDown E{WSP(int, WS_SLOTTOK), WSP(float, WS_SLOTW), WSP(unsigned char, WS_YB)};
        pg8::gemm_phase<epi::EpiDown, epi::LateOrder, true, false>(lds + RING_OFF, g, S, E);
    }
    SEAM(10);
    if (IN(11)) REP(11) {
        const bf16* X1B = WSP(bf16, WS_X1B); const unsigned char* YB = WSP(unsigned char, WS_YB); float* outp = KA->out;
        f32x4 gn[4];
#pragma unroll
        for (int j = 0; j < 4; ++j) gn[j] = *((const GAS f32x4*)FIN(19) + lane + 64 * j);
        for (int m = gw; m < T; m += NGW) {
            const GAS u32x2v* xr = (const GAS u32x2v*)(X1B + (size_t)m * DM) + lane;
            const GAS unsigned* y0 = (const GAS unsigned*)(YB + (size_t)(2 * m) * DM) + lane; const GAS unsigned* y1 = (const GAS unsigned*)(YB + (size_t)(2 * m + 1) * DM) + lane;
            f32x4 v[4]; float s2 = 0.f;
#pragma unroll
            for (int j = 0; j < 4; ++j) { const u32x2v c = xr[64 * j]; const int a = (int)y0[64 * j], b = (int)y1[64 * j];
                const f32x2v a0 = __builtin_amdgcn_cvt_pk_f32_fp8(a, false), a1 = __builtin_amdgcn_cvt_pk_f32_fp8(a, true), b0 = __builtin_amdgcn_cvt_pk_f32_fp8(b, false), b1 = __builtin_amdgcn_cvt_pk_f32_fp8(b, true);
                v[j].x = bflo(c.x) + (a0.x + b0.x) * (1.0f / YB_SCALE); v[j].y = bfhi(c.x) + (a0.y + b0.y) * (1.0f / YB_SCALE); v[j].z = bflo(c.y) + (a1.x + b1.x) * (1.0f / YB_SCALE); v[j].w = bfhi(c.y) + (a1.y + b1.y) * (1.0f / YB_SCALE);
                s2 += (v[j].x * v[j].x + v[j].y * v[j].y) + (v[j].z * v[j].z + v[j].w * v[j].w); }
            const float rstd = rsqrtf(wave_sum(s2) * (1.f / DM) + EPS);
            GAS f32x4* orow = (GAS f32x4*)(outp + (size_t)m * DM) + lane;
#pragma unroll
            for (int j = 0; j < 4; ++j) orow[64 * j] = v[j] * rstd * gn[j];
        }
    }
#undef IN
#undef SEAM
}

#ifndef MK_N_LAUNCHES
#define MK_N_LAUNCHES 1
#endif
extern "C" void kernel_launch(void* const* d_in, const int* in_sizes, int n_in, void* d_out, int out_size, void* d_ws, size_t ws_size, hipStream_t stream) {
    static int grid = 0;
    if (grid == 0) {
        if (n_in != 20 || in_sizes[0] != T * DM || out_size != T * DM || ws_size < WS_END) { fprintf(stderr, "kernel_launch: unexpected shapes (n_in %d, in0 %d, out %d, ws %zu)\n", n_in, n_in > 0 ? in_sizes[0] : -1, out_size, ws_size); grid = -1; return; }
        int dev = 0, cus = 0, per_cu = 0;
        if (hipGetDevice(&dev) != hipSuccess || hipDeviceGetAttribute(&cus, hipDeviceAttributeMultiprocessorCount, dev) != hipSuccess) { grid = -1; return; }
        if (hipFuncSetAttribute((const void*)fwd_kernel, hipFuncAttributeMaxDynamicSharedMemorySize, LDS_BYTES) != hipSuccess) { fprintf(stderr, "kernel_launch: hipFuncSetAttribute failed\n"); grid = -1; return; }
        if (hipOccupancyMaxActiveBlocksPerMultiprocessor(&per_cu, (const void*)fwd_kernel, NWAVES * 64, LDS_BYTES) != hipSuccess || per_cu < 1) { fprintf(stderr, "kernel_launch: occupancy query reports %d blocks per CU\n", per_cu); }
        (void)hipGetLastError();
        grid = cus;
    }
    if (grid < 0) return;
    if (hipMemsetAsync((char*)d_ws + WS_CTL, 0, CTL_ZERO_BYTES, stream) != hipSuccess) return;
    Args a{};
    for (int i = 0; i < 20; ++i) a.in[i] = d_in[i];
    a.out = (float*)d_out; a.ws = (unsigned char*)d_ws;
    if (MK_N_LAUNCHES == 1) { a.ph_lo = 0; a.ph_hi = NPHASE; hipLaunchKernelGGL(fwd_kernel, dim3(grid), dim3(NWAVES * 64), LDS_BYTES, stream, a); }
    else for (int p = 0; p < NPHASE; ++p) { a.ph_lo = p; a.ph_hi = p + 1; hipLaunchKernelGGL(fwd_kernel, dim3(grid), dim3(NWAVES * 64), LDS_BYTES, stream, a); }
}
```

```cpp
#include <hip/hip_runtime.h>
#include <cstdio>
#include <cstdint>
#include <cmath>
namespace pg8 {
#define PG8_LAS __attribute__((address_space(3)))
typedef unsigned short bf16_t;
typedef short bf16x8 __attribute__((ext_vector_type(8)));
typedef float f32x4 __attribute__((ext_vector_type(4)));
typedef unsigned u32x4 __attribute__((ext_vector_type(4)));
constexpr int BM = 256, BK = 64, HALF = 128, HTB = HALF * BK * 2  , STAGE_BYTES = 8 * HTB, NXCD = 8, WGM = 8;

__host__ __device__ __forceinline__ int lds_byte(int r, int c) { const int st = (r >> 4) * 2 + (c >> 5), rr = r & 15, cc = c & 31, ob = rr * 64 + cc * 2; return st * 1024 + (ob ^ (((ob >> 9) & 1) << 5)); }
__host__ __device__ __forceinline__ void stage_rc(int b, int& R, int& C) { const int st = b / 1024, sb = b % 1024, swz = sb ^ (((sb >> 9) & 1) << 5); R = (st >> 1) * 16 + swz / 64; C = (st & 1) * 32 + (swz % 64) / 2; }
__host__ __device__ __forceinline__ int perm32(int rho) { const int n = rho >> 4, i = rho & 15; return 8 * (i >> 2) + 4 * n + (i & 3); }

struct Unit { int pm, pn; };
struct Gemm { const bf16_t* A; const bf16_t* Bt; int M, N, K; const int* rowtok; };

struct StaticOrder {
    int nM, nN, nwg, G, c;
    __host__ __device__ __forceinline__ void init(int M, int N, int G_, int c_) { nM = M / BM; nN = N / BM; nwg = nM * nN; G = G_; c = c_; }
    __host__ __device__ __forceinline__ bool next(int i, Unit& u) const {
        const long L = (long)i * G + c; if (L >= nwg) return false;
        int wgid = (int)L; { const int q = nwg / NXCD, r = nwg % NXCD, xcd = wgid % NXCD, off = wgid / NXCD; wgid = (xcd < r ? xcd * (q + 1) : r * (q + 1) + (xcd - r) * q) + off; }
        const int nig = WGM * nN, gid = wgid / nig, fm = gid * WGM, gsz = (nM - fm) < WGM ? (nM - fm) : WGM;
        u.pm = fm + ((wgid % nig) % gsz); u.pn = (wgid % nig) / gsz; return true;
    }
    __device__ __forceinline__ void a_ready(const Unit&) const {}
    __device__ __forceinline__ void done(const Unit&) const {}
};

typedef float f32x2_t __attribute__((ext_vector_type(2))); typedef __bf16 bf16x2_t __attribute__((ext_vector_type(2)));
__device__ __forceinline__ unsigned cvt_pk_bf16(float lo, float hi) { f32x2_t v = {lo, hi}; bf16x2_t b = __builtin_convertvector(v, bf16x2_t); return __builtin_bit_cast(unsigned, b); }

template <class Epi, class Sched, bool ALIGN_EPI, bool GATHER>
__device__ __forceinline__ void gemm_phase(PG8_LAS unsigned char* lds, const Gemm g, const Sched& S, const Epi& E) {
    const int tid = threadIdx.x, wid = __builtin_amdgcn_readfirstlane(tid >> 6), lane = tid & 63, wr = wid >> 2, wc = wid & 3, fr = lane & 15, fq = lane >> 4;
    const int K = g.K, nt = K / BK;
    unsigned voffA[2], voffB[2]; int RA[2], CA[2];
#pragma unroll
    for (int i = 0; i < 2; ++i) { int R, C; stage_rc(tid * 16 + i * 8192, R, C); const int Rb = Epi::PERM ? ((R & ~31) + perm32(R & 31)) : R;
        voffA[i] = (unsigned)(R * K + C) * 2u; voffB[i] = (unsigned)(Rb * K + C) * 2u; RA[i] = R; CA[i] = C; }
    const size_t kstep = (size_t)(BK * 2);
    const size_t hstep = (size_t)HALF * K * 2;
    const size_t tstep = 2 * hstep;
    const unsigned ldsw = (unsigned)wid * 1024u;
    const int aoff = lds_byte(wr * 64 + fr, fq * 8), boff = lds_byte(wc * 32 + fr, fq * 8);
#define PG8_SA(b, h) (((b) * 2 + (h)) * HTB)
#define PG8_SB(b, h) ((4 + (b) * 2 + (h)) * HTB)
#define PG8_STAGE(bufoff, gbase, voff) do { _Pragma("unroll") for (int _i = 0; _i < 2; ++_i) \
        __builtin_amdgcn_global_load_lds((const unsigned*)((const char*)(gbase) + (voff)[_i]), (PG8_LAS unsigned*)(lds + (bufoff) + ldsw + _i * 8192), 16, 0, 0); } while (0)
#define PG8_STAGE_A(b, h, p, OFF) do { if constexpr (GATHER) { PG8_STAGE(PG8_SA(b, h), (p), OFF[h]); } else { PG8_STAGE(PG8_SA(b, h), (p) + (h) * hstep, voffA); } } while (0)
#define PG8_LDA(dst, b, h) do { _Pragma("unroll") for (int m = 0; m < 4; ++m) _Pragma("unroll") for (int k = 0; k < 2; ++k) dst[m][k] = *(const PG8_LAS bf16x8*)(lds + PG8_SA(b, h) + aoff + m * 2048 + k * 1024); } while (0)
#define PG8_LDB(dst, b, h) do { _Pragma("unroll") for (int n = 0; n < 2; ++n) _Pragma("unroll") for (int k = 0; k < 2; ++k) dst[n][k] = *(const PG8_LAS bf16x8*)(lds + PG8_SB(b, h) + boff + n * 2048 + k * 1024); } while (0)
#define PG8_MMA(ai, bj, At, Bt) do { __builtin_amdgcn_s_setprio(1); _Pragma("unroll") for (int m = 0; m < 4; ++m) _Pragma("unroll") for (int n = 0; n < 2; ++n) _Pragma("unroll") for (int k = 0; k < 2; ++k) \
        acc[ai][bj][m][n] = __builtin_amdgcn_mfma_f32_16x16x32_bf16(Bt[n][k], At[m][k], acc[ai][bj][m][n], 0, 0, 0); __builtin_amdgcn_s_setprio(0); } while (0)
#define PG8_WAIT_V(n) asm volatile("s_waitcnt vmcnt(" #n ")" ::: "memory")
#define PG8_WAIT_L(n) asm volatile("s_waitcnt lgkmcnt(" #n ")" ::: "memory")
#define PG8_BAR __builtin_amdgcn_s_barrier()
#define PG8_SCHED __builtin_amdgcn_sched_barrier(0)
#define PG8_GOFF(dst, pm_) do { _Pragma("unroll") for (int _h = 0; _h < 2; ++_h) _Pragma("unroll") for (int _i = 0; _i < 2; ++_i) { \
        int _t = g.rowtok[(pm_) * BM + _h * HALF + RA[_i]]; _t = _t < 0 ? 0 : (_t >> 1); dst[_h][_i] = (unsigned)(_t * K + CA[_i]) * 2u; } } while (0)
    Unit cur, nxt; int ui = 0;
    if (!S.next(0, cur)) return;
    f32x4 acc[2][2][4][2];
    if constexpr (Epi::HAS_INIT) { E.init(acc, cur, wr, wc, fr, fq); } else {
#pragma unroll
    for (int a = 0; a < 2; ++a)
#pragma unroll
        for (int b = 0; b < 2; ++b)
#pragma unroll
            for (int m = 0; m < 4; ++m)
#pragma unroll
                for (int n = 0; n < 2; ++n) acc[a][b][m][n] = (f32x4){0.f, 0.f, 0.f, 0.f};
    }
    bf16x8 At[4][2], B0[2][2], B1[2][2];
    unsigned oC[2][2] = {{0u, 0u}, {0u, 0u}}, oN[2][2] = {{0u, 0u}, {0u, 0u}}, o2[2][2] = {{0u, 0u}, {0u, 0u}};
    if constexpr (GATHER) { PG8_GOFF(oC, cur.pm); }
    const char* cA = GATHER ? (const char*)g.A : (const char*)g.A + (size_t)cur.pm * tstep; const char* cB = (const char*)g.Bt + (size_t)cur.pn * tstep;
    S.a_ready(cur);
    PG8_STAGE(PG8_SB(0, 0), cB, voffB); PG8_STAGE(PG8_SB(0, 1), cB + hstep, voffB); PG8_STAGE_A(0, 0, cA, oC); PG8_STAGE_A(0, 1, cA, oC);
    if (wr == 1) PG8_BAR;
    PG8_WAIT_V(2); PG8_BAR;
    PG8_STAGE(PG8_SB(1, 0), cB + kstep, voffB); PG8_STAGE_A(1, 0, cA + kstep, oC); PG8_STAGE(PG8_SB(1, 1), cB + hstep + kstep, voffB);
    PG8_WAIT_V(6); PG8_BAR;
    for (;;) {
        const bool has_next = S.next(ui + 1, nxt);
        if constexpr (GATHER) { if (has_next) { PG8_GOFF(oN, nxt.pm); } }
        const char* nA = GATHER ? cA : (has_next ? (const char*)g.A + (size_t)nxt.pm * tstep : cA); const char* nB = has_next ? (const char*)g.Bt + (size_t)nxt.pn * tstep : cB;
#pragma clang loop unroll(disable)
        for (int t = 0; t < nt; t += 2) {
            const bool last = (t == nt - 2);
            const char* a1 = cA + (size_t)(t + 1) * kstep;
            const char* a2 = last ? nA : cA + (size_t)(t + 2) * kstep; const char* b2 = last ? nB : cB + (size_t)(t + 2) * kstep;
            const char* a3 = a2 + kstep; const char* b3 = b2 + kstep;
            if constexpr (GATHER) { const bool sel = last && has_next;
#pragma unroll
                for (int h = 0; h < 2; ++h)
#pragma unroll
                    for (int i = 0; i < 2; ++i) o2[h][i] = sel ? oN[h][i] : oC[h][i]; }
            if (last && has_next) S.a_ready(nxt);
            if constexpr (Epi::HAS_MIDK) { if (t == Epi::MIDT) E.midk(acc, cur, wr, wc, fr, fq); }
            PG8_LDB(B0, 0, 0); PG8_LDB(B1, 0, 1); PG8_SCHED; PG8_LDA(At, 0, 0); PG8_STAGE_A(1, 1, a1, oC);
            PG8_WAIT_V(8); PG8_WAIT_L(0); PG8_BAR; PG8_MMA(0, 0, At, B0); PG8_MMA(0, 1, At, B1); PG8_BAR; PG8_SCHED;
            PG8_LDA(At, 0, 1); PG8_STAGE(PG8_SB(0, 0), b2, voffB); PG8_STAGE(PG8_SB(0, 1), b2 + hstep, voffB); PG8_STAGE_A(0, 0, a2, o2);
            PG8_WAIT_V(8); PG8_WAIT_L(0); PG8_BAR; PG8_MMA(1, 0, At, B0); PG8_MMA(1, 1, At, B1); PG8_BAR; PG8_SCHED;
            PG8_LDB(B0, 1, 0); PG8_LDB(B1, 1, 1); PG8_SCHED; PG8_LDA(At, 1, 0); PG8_STAGE_A(0, 1, a2, o2);
            PG8_WAIT_V(8); PG8_WAIT_L(0); PG8_BAR; PG8_MMA(0, 0, At, B0); PG8_MMA(0, 1, At, B1); PG8_BAR; PG8_SCHED;
            PG8_LDA(At, 1, 1); PG8_STAGE(PG8_SB(1, 0), b3, voffB); PG8_STAGE(PG8_SB(1, 1), b3 + hstep, voffB); PG8_STAGE_A(1, 0, a3, o2);
            PG8_WAIT_V(8); PG8_WAIT_L(0); PG8_BAR; PG8_MMA(1, 0, At, B0); PG8_MMA(1, 1, At, B1); PG8_BAR; PG8_SCHED;
        }
        if constexpr (ALIGN_EPI) { if (wr == 0) PG8_BAR; }
        E(acc, cur, wr, wc, fr, fq); S.done(cur);
        if (!has_next) break;
        if constexpr (Epi::HAS_INIT) { E.init(acc, nxt, wr, wc, fr, fq); } else {
#pragma unroll
        for (int a = 0; a < 2; ++a)
#pragma unroll
            for (int b = 0; b < 2; ++b)
#pragma unroll
                for (int m = 0; m < 4; ++m)
#pragma unroll
                    for (int n = 0; n < 2; ++n) acc[a][b][m][n] = (f32x4){0.f, 0.f, 0.f, 0.f};
        }
        cur = nxt; cA = nA; cB = nB; ++ui;
        if constexpr (GATHER) {
#pragma unroll
            for (int h = 0; h < 2; ++h)
#pragma unroll
                for (int i = 0; i < 2; ++i) oC[h][i] = oN[h][i]; }
        if constexpr (ALIGN_EPI) { if (wr == 1) PG8_BAR; }
    }
    PG8_WAIT_V(0);
    if constexpr (!ALIGN_EPI) { if (wr == 0) PG8_BAR; }
    PG8_BAR;
#undef PG8_SA
#undef PG8_SB
#undef PG8_STAGE
#undef PG8_STAGE_A
#undef PG8_LDA
#undef PG8_LDB
#undef PG8_MMA
#undef PG8_WAIT_V
#undef PG8_WAIT_L
#undef PG8_BAR
#undef PG8_SCHED
#undef PG8_GOFF
}
}

constexpr int NWAVES = 8;
constexpr int BATCH = 32, SEQ = 2048, DM = 1024, T = BATCH * SEQ;
constexpr int NH = 8, HD = 64, SBW = 512, MLAW = 512, QLORA = 256, KVLORA = 128, ROPE = 32, NOPE = 64, QKD = 96;
constexpr int INC = 1952, INP = 2048;
constexpr int NEXP = 32, NGRP = 4, EPG = 8, DEXP = 256;
constexpr int MAXTILES = 544;
constexpr float EPS = 1e-6f;
constexpr float LOG2E = 1.4426950408889634f;
constexpr float SB_C2 = 0.125f * LOG2E;
constexpr float YB_SCALE = 8.0f;
constexpr float MLA_C2 = 0.10206207261596575f * LOG2E;

constexpr size_t MiB = 1u << 20;
constexpr size_t WS_CTL = 0, CTL_ZERO_BYTES = 1 * MiB;
constexpr size_t WS_WIN = 2 * MiB;
constexpr size_t WS_WUQ = 6 * MiB;
constexpr size_t WS_WUKV = 7 * MiB;
constexpr size_t WS_WOUT = 8 * MiB;
constexpr size_t WS_WR = 10 * MiB;
constexpr size_t WS_WGU = 11 * MiB;
constexpr size_t WS_WD = 43 * MiB;
constexpr size_t WS_TAB = 60 * MiB;
constexpr size_t WS_SSQQ = 68 * MiB;
constexpr size_t WS_SSQKV = 69 * MiB;
constexpr size_t WS_OSS = 70 * MiB;
constexpr size_t WS_SSQ2 = 74 * MiB;
constexpr size_t WS_RSTD2 = 78 * MiB;
constexpr size_t WS_INV1 = 78 * MiB + 512 * 1024;
constexpr size_t WS_RS3 = 105 * MiB;
constexpr size_t WS_EIDX = 79 * MiB;
constexpr size_t WS_EW = 80 * MiB;
constexpr size_t WS_RANK = 81 * MiB;
constexpr size_t WS_CNT = 82 * MiB;
constexpr size_t WS_TILEE = 82 * MiB + 65536;
constexpr size_t WS_SLOTTOK = 83 * MiB;
constexpr size_t WS_SLOTW = 84 * MiB;
constexpr size_t WS_SLOTRS = 84 * MiB + 640 * 1024;
constexpr size_t WS_LOGITS = 85 * MiB;
constexpr size_t WS_KROPE = 101 * MiB;
constexpr size_t WS_H = 106 * MiB;
constexpr size_t WS_QM = 874 * MiB;
constexpr size_t WS_X1B = 234 * MiB;
constexpr size_t WS_QS = 234 * MiB, WS_KS = 298 * MiB, WS_VS = 362 * MiB;
constexpr size_t WS_CQ = 426 * MiB;
constexpr size_t WS_CKV = 458 * MiB;
constexpr size_t WS_X1 = 234 * MiB;
constexpr size_t WS_KVM = 490 * MiB;
constexpr size_t WS_HID = 490 * MiB;
constexpr size_t WS_O = 618 * MiB;
constexpr size_t WS_YB = 618 * MiB;
constexpr size_t WS_END = 970 * MiB;
constexpr int CW_BAR = 4096;
constexpr int CW_LATE = 16384, CW_LATE_TMO = 16384 + 64 * 64;

constexpr int RING_OFF = 0, RING_BYTES = 131072;
constexpr int LDSCTL_OFF = RING_BYTES, MISC_OFF = LDSCTL_OFF + 320;
constexpr int LDS_BYTES = 147456;

#define GAS __attribute__((address_space(1)))
#define LAS __attribute__((address_space(3)))
typedef unsigned short bf16;
typedef unsigned v4u __attribute__((ext_vector_type(4)));
typedef float f32x4 __attribute__((ext_vector_type(4)));
typedef short bf16x8 __attribute__((ext_vector_type(8)));
typedef GAS unsigned gu32;
typedef GAS unsigned long long gu64;
#define RLX_AGENT __ATOMIC_RELAXED, __HIP_MEMORY_SCOPE_AGENT
#define LDS_WAIT() asm volatile("s_waitcnt lgkmcnt(0)" ::: "memory")
#define VM_WAIT() asm volatile("s_waitcnt vmcnt(0)" ::: "memory")
__device__ __forceinline__ unsigned long long rt() { return __builtin_amdgcn_s_memrealtime(); }
__device__ __forceinline__ unsigned f2bf(float f) { unsigned u = __builtin_bit_cast(unsigned, f); return (u + 0x7fffu + ((u >> 16) & 1u)) >> 16; }
__device__ __forceinline__ unsigned pk2(float lo, float hi) { return f2bf(lo) | (f2bf(hi) << 16); }

#define XB_TMO      128
#define XB_XCNT(j)  (256  + 64 * (j))
#define XB_XSUB(j)  (1280 + 64 * (j))
#define XB_XGEN(j)  (2304 + 64 * (j))
#define XB_TOP      3328
#define XB_TOPGEN   3392
#define XCD_BAR_WORDS 3456
#define XB_SPIN_CAP (1u << 18)

__device__ __forceinline__ unsigned xb_ld(unsigned* p)              { return __hip_atomic_load(p, __ATOMIC_RELAXED, __HIP_MEMORY_SCOPE_AGENT); }
__device__ __forceinline__ unsigned xb_add(unsigned* p, unsigned v) { return __hip_atomic_fetch_add(p, v, __ATOMIC_RELAXED, __HIP_MEMORY_SCOPE_AGENT); }
__device__ __forceinline__ unsigned xb_xcc_id() { return (unsigned)__builtin_amdgcn_s_getreg((3 << 11) | 20) & 0xFu; }
#define XB_SPIN(cond, bar) do { unsigned _sp = 0; while (cond) { __builtin_amdgcn_s_sleep(1); \
    if ((++_sp & 255u) == 0u) { if (xb_ld(&(bar)[XB_TMO])) break; if (_sp > XB_SPIN_CAP) { atomicAdd(&(bar)[XB_TMO], 1u); break; } } } } while (0)

struct XcdBarrier {
    unsigned* bar; unsigned x;
    volatile LAS unsigned* st;
};

__device__ __forceinline__ XcdBarrier xcd_barrier_post(unsigned* bar, volatile LAS unsigned* st) {
    XcdBarrier b; b.bar = bar; b.x = xb_xcc_id(); b.st = st;
    if (threadIdx.x == 0) (void)xb_add(&bar[XB_XCNT(b.x)], 1u);
    return b;
}
__device__ __forceinline__ void xcd_barrier_complete(unsigned* bar, unsigned x, unsigned& nloc, unsigned& nx) {
    const unsigned G = gridDim.x * gridDim.y * gridDim.z;
    unsigned sum, cnt, mine, sp = 0u;
    for (;;) {
        sum = 0u; cnt = 0u; mine = 0u;
#pragma unroll
        for (unsigned j = 0; j < 16; ++j) { const unsigned c = xb_ld(&bar[XB_XCNT(j)]); sum += c; cnt += (c > 0u) ? 1u : 0u; mine = (j == x) ? c : mine; }
        if (sum == G) break;
        __builtin_amdgcn_s_sleep(1);
        if ((++sp & 255u) == 0u) { if (xb_ld(&bar[XB_TMO])) break; if (sp > XB_SPIN_CAP) { atomicAdd(&bar[XB_TMO], 1u); break; } }
    }
    nloc = mine > 0u ? mine : 1u; nx = cnt > 0u ? cnt : 1u;
}

__device__ __forceinline__ void xcd_barrier(const XcdBarrier& b) {
    asm volatile("s_waitcnt vmcnt(0)" ::: "memory");
    __syncthreads();
    if (threadIdx.x == 0) {
        unsigned* bar = b.bar;
        __builtin_amdgcn_s_waitcnt(0);
        unsigned nloc = b.st[0], nx = b.st[1];
        if (nloc == 0u) { xcd_barrier_complete(bar, b.x, nloc, nx); b.st[0] = nloc; b.st[1] = nx; }
        const unsigned old = xb_add(&bar[XB_XSUB(b.x)], 1u);
        const unsigned gen = old / nloc;
        if (old + 1u == (gen + 1u) * nloc) {
            __builtin_amdgcn_fence(__ATOMIC_RELEASE, "agent");
            asm volatile("s_waitcnt vmcnt(0)" ::: "memory");
            const unsigned og = xb_add(&bar[XB_TOP], 1u);
            const unsigned tg = og / nx;
            if (og + 1u == (tg + 1u) * nx) xb_add(&bar[XB_TOPGEN], 1u);
            else XB_SPIN(xb_ld(&bar[XB_TOPGEN]) == tg, bar);
            __builtin_amdgcn_fence(__ATOMIC_ACQUIRE, "agent");
            xb_add(&bar[XB_XGEN(b.x)], 1u);
            asm volatile("s_waitcnt vmcnt(0)" ::: "memory");
        } else {
            XB_SPIN(xb_ld(&bar[XB_XGEN(b.x)]) == gen, bar);
            __builtin_amdgcn_fence(__ATOMIC_ACQUIRE, "agent");
            asm volatile("s_waitcnt vmcnt(0)" ::: "memory");
        }
    }
    __syncthreads();
}

typedef float f32x2v __attribute__((ext_vector_type(2)));
typedef unsigned u32x2v __attribute__((ext_vector_type(2)));
namespace epi {
using pg8::f32x4; using pg8::u32x4; using pg8::Unit; using pg8::bf16_t; using pg8::cvt_pk_bf16;
typedef float f32x2 __attribute__((ext_vector_type(2)));
typedef unsigned u32x2 __attribute__((ext_vector_type(2)));
__device__ __forceinline__ u32x4 pack8(const f32x4 a, const f32x4 b) { u32x4 w; w.x = cvt_pk_bf16(a[0], a[1]); w.y = cvt_pk_bf16(a[2], a[3]); w.z = cvt_pk_bf16(b[0], b[1]); w.w = cvt_pk_bf16(b[2], b[3]); return w; }
__device__ __forceinline__ float sq8(const f32x4 a, const f32x4 b) { return (a[0] * a[0] + a[1] * a[1]) + (a[2] * a[2] + a[3] * a[3]) + (b[0] * b[0] + b[1] * b[1]) + (b[2] * b[2] + b[3] * b[3]); }
__device__ __forceinline__ void rope8(f32x4& a, f32x4& b, const u32x4 tb) {
    const float c0 = __builtin_bit_cast(float, tb[0] << 16), s0 = __builtin_bit_cast(float, tb[0] & 0xffff0000u), c1 = __builtin_bit_cast(float, tb[1] << 16), s1 = __builtin_bit_cast(float, tb[1] & 0xffff0000u);
    const float c2 = __builtin_bit_cast(float, tb[2] << 16), s2 = __builtin_bit_cast(float, tb[2] & 0xffff0000u), c3 = __builtin_bit_cast(float, tb[3] << 16), s3 = __builtin_bit_cast(float, tb[3] & 0xffff0000u);
    f32x4 ra, rb;
    ra[0] = a[0] * c0 - a[1] * s0; ra[1] = a[1] * c0 + a[0] * s0;
    ra[2] = a[2] * c1 - a[3] * s1; ra[3] = a[3] * c1 + a[2] * s1;
    rb[0] = b[0] * c2 - b[1] * s2; rb[1] = b[1] * c2 + b[0] * s2;
    rb[2] = b[2] * c3 - b[3] * s3; rb[3] = b[3] * c3 + b[2] * s3;
    a = ra; b = rb;
}

struct EpiProj {
    static constexpr bool PERM = true, HAS_INIT = false, HAS_MIDK = false;
    bf16_t *QKV, *CQ, *CKV, *KROPE; float *SSQQ, *SSQKV; const unsigned* TAB;
    __device__ __forceinline__ void operator()(const f32x4 (&acc)[2][2][4][2], const Unit& u, int wr, int wc, int fr, int fq) const {
        const int pn = u.pn; int rowv = u.pm * 256 + wr * 64 + fr;
        if (pn < 6) {
            bf16_t* dst = QKV + (size_t)(pn >> 1) * ((size_t)T * 512) + (pn & 1) * 256 + wc * 32 + 8 * fq; const float sc = (pn < 2) ? SB_C2 : 1.0f;
#pragma unroll
            for (int ai = 0; ai < 2; ++ai)
#pragma unroll
                for (int m = 0; m < 4; ++m) { asm volatile("" : "+v"(rowv)); const int row = rowv; rowv += (m == 3) ? 80 : 16;
#pragma unroll
                    for (int bj = 0; bj < 2; ++bj) *(u32x4*)(dst + (size_t)row * 512 + bj * 128) = pack8(acc[ai][bj][m][0] * sc, acc[ai][bj][m][1] * sc); }
        } else if (pn == 6) {
#pragma unroll
            for (int ai = 0; ai < 2; ++ai)
#pragma unroll
                for (int m = 0; m < 4; ++m) { asm volatile("" : "+v"(rowv)); const int row = rowv; rowv += (m == 3) ? 80 : 16; float s = 0.f;
#pragma unroll
                    for (int bj = 0; bj < 2; ++bj) { const int c = bj * 128 + wc * 32 + 8 * fq;
                        *(u32x4*)(CQ + (size_t)row * 256 + c) = pack8(acc[ai][bj][m][0], acc[ai][bj][m][1]); s += sq8(acc[ai][bj][m][0], acc[ai][bj][m][1]); }
                    s += __shfl_xor(s, 16); s += __shfl_xor(s, 32);
                    if (fq == 0) SSQQ[(size_t)row * 4 + wc] = s; }
        } else {
#pragma unroll
            for (int ai = 0; ai < 2; ++ai)
#pragma unroll
                for (int m = 0; m < 4; ++m) { asm volatile("" : "+v"(rowv)); const int row = rowv; rowv += (m == 3) ? 80 : 16;
                    { const int c = wc * 32 + 8 * fq;
                      *(u32x4*)(CKV + (size_t)row * 128 + c) = pack8(acc[ai][0][m][0], acc[ai][0][m][1]);
                      float s = sq8(acc[ai][0][m][0], acc[ai][0][m][1]); s += __shfl_xor(s, 16); s += __shfl_xor(s, 32);
                      if (fq == 0) SSQKV[(size_t)row * 4 + wc] = s; }
                    if (wc == 0) {
                        f32x4 a = acc[ai][1][m][0], b = acc[ai][1][m][1];
                        rope8(a, b, *(const u32x4*)(TAB + (size_t)row * 16 + 4 * fq));
                        *(u32x4*)(KROPE + (size_t)row * 32 + 8 * fq) = pack8(a, b);
                    }
                    if (m & 1) asm volatile("" ::: "memory"); }
        }
    }
};

struct EpiQup {
    static constexpr bool PERM = true, HAS_INIT = false, HAS_MIDK = false;
    bf16_t* QM; const float* SSQQ; const unsigned* TAB;
    __device__ __forceinline__ void operator()(const f32x4 (&acc)[2][2][4][2], const Unit& u, int wr, int wc, int fr, int fq) const {
        const int row0 = u.pm * 256 + wr * 64 + fr;
        float rs[8];
#pragma unroll
        for (int i = 0; i < 8; ++i) { const f32x4 ss = *(const f32x4*)(SSQQ + (size_t)(row0 + (i >> 2) * 128 + (i & 3) * 16) * 4); rs[i] = rsqrtf(((ss[0] + ss[1]) + (ss[2] + ss[3])) * (1.0f / QLORA) + EPS) * MLA_C2; }
#pragma unroll
        for (int bj = 0; bj < 2; ++bj) {
            const int cc = u.pn * 256 + bj * 128 + wc * 32 + 8 * fq, jo = cc % QKD - NOPE;
            u32x4 tb[8];
            if (jo >= 0) { int rl = row0; asm volatile("" : "+v"(rl));
#pragma unroll
                for (int i = 0; i < 8; ++i) { tb[i] = *(const u32x4*)(TAB + (size_t)rl * 16 + (jo >> 1)); rl += ((i & 3) == 3) ? 80 : 16; }
            }
            int rowv = row0;
#pragma unroll
            for (int i = 0; i < 8; ++i) { const int ai = i >> 2, m = i & 3; asm volatile("" : "+v"(rowv)); const int row = rowv; rowv += (m == 3) ? 80 : 16;
                f32x4 a = acc[ai][bj][m][0] * rs[i], b = acc[ai][bj][m][1] * rs[i];
                if (jo >= 0) rope8(a, b, tb[i]);
                *(u32x4*)(QM + (size_t)row * 768 + cc) = pack8(a, b); }
            asm volatile("" ::: "memory");
        }
    }
};
struct EpiKVup {
    static constexpr bool PERM = true, HAS_INIT = false, HAS_MIDK = false;
    bf16_t* KVM; const float* SSQKV;
    __device__ __forceinline__ void operator()(const f32x4 (&acc)[2][2][4][2], const Unit& u, int wr, int wc, int fr, int fq) const {
        const int row0 = u.pm * 256 + wr * 64 + fr;
        float rs[8];
#pragma unroll
        for (int i = 0; i < 8; ++i) { const f32x4 ss = *(const f32x4*)(SSQKV + (size_t)(row0 + (i >> 2) * 128 + (i & 3) * 16) * 4); rs[i] = rsqrtf(((ss[0] + ss[1]) + (ss[2] + ss[3])) * (1.0f / KVLORA) + EPS); }
        int rowv = row0;
#pragma unroll
        for (int ai = 0; ai < 2; ++ai)
#pragma unroll
            for (int m = 0; m < 4; ++m) {
                asm volatile("" : "+v"(rowv)); const int row = rowv; rowv += (m == 3) ? 80 : 16;
#pragma unroll
                for (int bj = 0; bj < 2; ++bj) { const int c = u.pn * 256 + bj * 128 + wc * 32 + 8 * fq;
                    *(u32x4*)(KVM + (size_t)row * 1024 + c) = pack8(acc[ai][bj][m][0] * rs[ai * 4 + m], acc[ai][bj][m][1] * rs[ai * 4 + m]); }
            }
    }
};
struct EpiX1 {
    static constexpr bool PERM = true, HAS_INIT = true, HAS_MIDK = true; static constexpr int MIDT = 8;
    const bf16_t* H; const float* G1; bf16_t* X1B; float* SSQ2; const float* OSS; const float* INV1; __attribute__((address_space(3))) float* rsl;
    __device__ __forceinline__ void init(f32x4 (&acc)[2][2][4][2], const Unit& u, int wr, int wc, int fr, int fq) const {
        const int row0 = u.pm * 256 + wr * 64 + fr; const int c0 = u.pn * 256 + wc * 32 + 8 * fq;
        const bf16_t* hp = H + (size_t)row0 * 1024 + c0;
        f32x4 ig[2][2];
#pragma unroll
        for (int bj = 0; bj < 2; ++bj)
#pragma unroll
            for (int n = 0; n < 2; ++n) { const f32x4 gv = *(const f32x4*)(G1 + c0 + bj * 128 + 4 * n);
                ig[bj][n] = (f32x4){__builtin_amdgcn_rcpf(gv[0]), __builtin_amdgcn_rcpf(gv[1]), __builtin_amdgcn_rcpf(gv[2]), __builtin_amdgcn_rcpf(gv[3])}; }
#pragma unroll
        for (int ai = 0; ai < 2; ++ai)
#pragma unroll
            for (int m = 0; m < 4; ++m) {
                const int row = row0 + ai * 128 + m * 16; const f32x4* sp = (const f32x4*)(OSS + (size_t)row * 16);
                const f32x4 s0 = sp[0], s1 = sp[1], s2 = sp[2], s3 = sp[3];
                const float vs = (((s0[0] + s0[1]) + (s0[2] + s0[3])) + ((s1[0] + s1[1]) + (s1[2] + s1[3]))) * (1.f / 512.f) + 1e-6f, vm = (((s2[0] + s2[1]) + (s2[2] + s2[3])) + ((s3[0] + s3[1]) + (s3[2] + s3[3]))) * (1.f / 512.f) + 1e-6f;
                const float is = sqrtf(vs) * INV1[row];
                { __attribute__((address_space(3))) float* rp = rsl + (((wr * 4 + wc) * 8 + ai * 4 + m) * 16 + fr) * 2; rp[0] = rsqrtf(vs) * sqrtf(vm); rp[1] = rsqrtf(vm); }
#pragma unroll
                for (int bj = 0; bj < 2; ++bj) { const u32x4 hv = *(const u32x4*)(hp + (size_t)(ai * 128 + m * 16) * 1024 + bj * 128);
                    const f32x4 lo = {__builtin_bit_cast(float, hv[0] << 16), __builtin_bit_cast(float, hv[0] & 0xffff0000u), __builtin_bit_cast(float, hv[1] << 16), __builtin_bit_cast(float, hv[1] & 0xffff0000u)};
                    const f32x4 hi = {__builtin_bit_cast(float, hv[2] << 16), __builtin_bit_cast(float, hv[2] & 0xffff0000u), __builtin_bit_cast(float, hv[3] << 16), __builtin_bit_cast(float, hv[3] & 0xffff0000u)};
                    acc[ai][bj][m][0] = lo * ig[bj][0] * is; acc[ai][bj][m][1] = hi * ig[bj][1] * is; } }
    }
    __device__ __forceinline__ void midk(f32x4 (&acc)[2][2][4][2], const Unit& u, int wr, int wc, int fr, int fq) const {
        const int row0 = u.pm * 256 + wr * 64 + fr;
#pragma unroll
        for (int ai = 0; ai < 2; ++ai)
#pragma unroll
            for (int m = 0; m < 4; ++m) { const float rt = rsl[(((wr * 4 + wc) * 8 + ai * 4 + m) * 16 + fr) * 2];
#pragma unroll
                for (int bj = 0; bj < 2; ++bj) { acc[ai][bj][m][0] *= rt; acc[ai][bj][m][1] *= rt; } }
    }
    __device__ __forceinline__ void operator()(const f32x4 (&acc)[2][2][4][2], const Unit& u, int wr, int wc, int fr, int fq) const {
        const int row0 = u.pm * 256 + wr * 64 + fr;
        float rm[8];
#pragma unroll
        for (int i = 0; i < 8; ++i) rm[i] = rsl[(((wr * 4 + wc) * 8 + i) * 16 + fr) * 2 + 1];
        int rowv = row0;
#pragma unroll
        for (int ai = 0; ai < 2; ++ai)
#pragma unroll
            for (int m = 0; m < 4; ++m) {
                asm volatile("" : "+v"(rowv)); const int row = rowv; rowv += (m == 3) ? 80 : 16; float s = 0.f;
#pragma unroll
                for (int bj = 0; bj < 2; ++bj) { const size_t off = (size_t)row * 1024 + u.pn * 256 + bj * 128 + wc * 32 + 8 * fq;
                    const f32x4 a = acc[ai][bj][m][0] * rm[ai * 4 + m], b = acc[ai][bj][m][1] * rm[ai * 4 + m];
                    *(u32x4*)(X1B + off) = pack8(a, b); s += sq8(a, b); }
                s += __shfl_xor(s, 16); s += __shfl_xor(s, 32);
                if (fq == 0) SSQ2[(size_t)row * 16 + u.pn * 4 + wc] = s;
            }
    }
};
struct EpiRouter {
    static constexpr bool PERM = true, HAS_INIT = false, HAS_MIDK = false;
    const float* SSQ2; float* RSTD2; const float* BG; const float* BE; int* EIDX; float* EW; __attribute__((address_space(3))) int* ebuf;
    __device__ __forceinline__ void operator()(const f32x4 (&acc)[2][2][4][2], const Unit& u, int wr, int wc, int fr, int fq) const {
        if (wc != 0) return;
        const f32x4 bg = *(const f32x4*)BG, be0 = *(const f32x4*)(BE + 8 * fq), be1 = *(const f32x4*)(BE + 8 * fq + 4);
        int rowv = u.pm * 256 + wr * 64 + fr; int rlv = wr * 64 + fr;
#pragma unroll
        for (int ai = 0; ai < 2; ++ai)
#pragma unroll
            for (int m = 0; m < 4; ++m) {
                asm volatile("" : "+v"(rowv)); const int row = rowv; rowv += (m == 3) ? 80 : 16; const int rloc = rlv; rlv += (m == 3) ? 80 : 16;
                const f32x4 s0 = *(const f32x4*)(SSQ2 + (size_t)row * 16), s1 = *(const f32x4*)(SSQ2 + (size_t)row * 16 + 4), s2 = *(const f32x4*)(SSQ2 + (size_t)row * 16 + 8), s3 = *(const f32x4*)(SSQ2 + (size_t)row * 16 + 12);
                const float tot = (((s0[0] + s0[1]) + (s0[2] + s0[3])) + ((s1[0] + s1[1]) + (s1[2] + s1[3]))) + (((s2[0] + s2[1]) + (s2[2] + s2[3])) + ((s3[0] + s3[1]) + (s3[2] + s3[3])));
                const float rs = rsqrtf(tot * (1.0f / DM) + EPS);
                if (fq == 0) RSTD2[row] = rs;
                const f32x4 lg = acc[ai][0][m][0] * rs + bg;
                int gi = 0; float gm = lg[0];
                if (lg[1] > gm) { gm = lg[1]; gi = 1; } if (lg[2] > gm) { gm = lg[2]; gi = 2; } if (lg[3] > gm) { gm = lg[3]; gi = 3; }
                float gval = 1.0f / ((expf(lg[0] - gm) + expf(lg[1] - gm)) + (expf(lg[2] - gm) + expf(lg[3] - gm)));
                gi = __shfl(gi, fr); gval = __shfl(gval, fr);
                const f32x4 ea = acc[ai][1][m][0] * rs + be0, eb = acc[ai][1][m][1] * rs + be1;
                int i1 = 0; float m1 = ea[0];
                if (ea[1] > m1) { m1 = ea[1]; i1 = 1; } if (ea[2] > m1) { m1 = ea[2]; i1 = 2; } if (ea[3] > m1) { m1 = ea[3]; i1 = 3; }
                if (eb[0] > m1) { m1 = eb[0]; i1 = 4; } if (eb[1] > m1) { m1 = eb[1]; i1 = 5; } if (eb[2] > m1) { m1 = eb[2]; i1 = 6; } if (eb[3] > m1) { m1 = eb[3]; i1 = 7; }
                int i2 = -1; float m2 = -INFINITY;
                if (i1 != 0 && ea[0] > m2) { m2 = ea[0]; i2 = 0; } if (i1 != 1 && ea[1] > m2) { m2 = ea[1]; i2 = 1; } if (i1 != 2 && ea[2] > m2) { m2 = ea[2]; i2 = 2; } if (i1 != 3 && ea[3] > m2) { m2 = ea[3]; i2 = 3; }
                if (i1 != 4 && eb[0] > m2) { m2 = eb[0]; i2 = 4; } if (i1 != 5 && eb[1] > m2) { m2 = eb[1]; i2 = 5; } if (i1 != 6 && eb[2] > m2) { m2 = eb[2]; i2 = 6; } if (i1 != 7 && eb[3] > m2) { m2 = eb[3]; i2 = 7; }
                if (fq == gi) {
                    const float r = expf(m2 - m1);
                    const int e0 = fq * EPG + i1, e1 = fq * EPG + i2;
                    EIDX[row * 2] = e0; EIDX[row * 2 + 1] = e1; EW[row * 2] = gval / (1.0f + r); EW[row * 2 + 1] = gval * r / (1.0f + r);
                    ebuf[rloc * 2] = e0; ebuf[rloc * 2 + 1] = e1;
                }
                if (m & 1) asm volatile("" ::: "memory");
            }
    }
};
struct OneUnit {
    Unit u;
    __device__ __forceinline__ bool next(int i, Unit& o) const { if (i != 0) return false; o = u; return true; }
    __device__ __forceinline__ void a_ready(const Unit&) const {}
    __device__ __forceinline__ void done(const Unit&) const {}
};
struct EpiGateUp {
    static constexpr bool PERM = true, HAS_INIT = false, HAS_MIDK = false;
    const float* SLOTRS; bf16_t* HID;
    __device__ __forceinline__ void operator()(const f32x4 (&acc)[2][2][4][2], const Unit& u, int wr, int wc, int fr, int fq) const {
        const int pnl = u.pn & 1; const int slot0 = u.pm * 256 + wr * 64 + fr;
        float rsv[8];
#pragma unroll
        for (int i = 0; i < 8; ++i) rsv[i] = SLOTRS[slot0 + (i >> 2) * 128 + (i & 3) * 16];
        const bool odd = fq & 1;
        int rowv = slot0 + (odd ? 16 : 0);
#pragma unroll
        for (int ai = 0; ai < 2; ++ai)
#pragma unroll
            for (int j = 0; j < 2; ++j) {
                asm volatile("" : "+v"(rowv)); const int slot = rowv; rowv += (j == 1) ? 96 : 32; const float rs0 = rsv[ai * 4 + 2 * j], rs1 = rsv[ai * 4 + 2 * j + 1];
#pragma unroll
                for (int bj = 0; bj < 2; ++bj) { const int hc = pnl * 128 + bj * 64 + wc * 16 + 4 * (fq & 2);
                    const f32x4 gt0 = acc[ai][bj][2 * j][0] * rs0, up0 = acc[ai][bj][2 * j][1] * rs0, gt1 = acc[ai][bj][2 * j + 1][0] * rs1, up1 = acc[ai][bj][2 * j + 1][1] * rs1; f32x4 h0, h1;
#pragma unroll
                    for (int i = 0; i < 4; ++i) { h0[i] = gt0[i] * up0[i] * __builtin_amdgcn_rcpf(1.0f + __builtin_amdgcn_exp2f(-gt0[i] * LOG2E)); h1[i] = gt1[i] * up1[i] * __builtin_amdgcn_rcpf(1.0f + __builtin_amdgcn_exp2f(-gt1[i] * LOG2E)); }
                    const unsigned A0 = cvt_pk_bf16(h0[0], h0[1]), A1 = cvt_pk_bf16(h0[2], h0[3]), B0 = cvt_pk_bf16(h1[0], h1[1]), B1 = cvt_pk_bf16(h1[2], h1[3]);
                    const unsigned r0 = (unsigned)__shfl_xor((int)(odd ? A0 : B0), 16), r1 = (unsigned)__shfl_xor((int)(odd ? A1 : B1), 16);
                    const u32x4 o = {odd ? r0 : A0, odd ? r1 : A1, odd ? B0 : r0, odd ? B1 : r1};
                    *(u32x4*)(HID + (size_t)slot * 256 + hc) = o; }
            }
    }
};
struct EpiDown {
    static constexpr bool PERM = true, HAS_INIT = false, HAS_MIDK = false;
    const int* SLOTTOK; const float* SLOTW; unsigned char* YB;
    __device__ __forceinline__ void operator()(const f32x4 (&acc)[2][2][4][2], const Unit& u, int wr, int wc, int fr, int fq) const {
        const int pnl = u.pn & 3; const int slot0 = u.pm * 256 + wr * 64 + fr;
        int st[8]; float wv[8];
#pragma unroll
        for (int i = 0; i < 8; ++i) { st[i] = SLOTTOK[slot0 + (i >> 2) * 128 + (i & 3) * 16]; wv[i] = SLOTW[slot0 + (i >> 2) * 128 + (i & 3) * 16] * YB_SCALE; }
        const bool odd = fq & 1;
#pragma unroll
        for (int ai = 0; ai < 2; ++ai)
#pragma unroll
            for (int j = 0; j < 2; ++j) {
                const int i0 = ai * 4 + 2 * j, i1 = i0 + 1;
                const int sti = odd ? st[i1] : st[i0];
#pragma unroll
                for (int bj = 0; bj < 2; ++bj) {
                    const f32x4 a0 = acc[ai][bj][2 * j][0] * wv[i0], b0 = acc[ai][bj][2 * j][1] * wv[i0], a1 = acc[ai][bj][2 * j + 1][0] * wv[i1], b1 = acc[ai][bj][2 * j + 1][1] * wv[i1];
                    int A_lo = __builtin_amdgcn_cvt_pk_fp8_f32(a0[0], a0[1], 0, false); A_lo = __builtin_amdgcn_cvt_pk_fp8_f32(a0[2], a0[3], A_lo, true);
                    int A_hi = __builtin_amdgcn_cvt_pk_fp8_f32(b0[0], b0[1], 0, false); A_hi = __builtin_amdgcn_cvt_pk_fp8_f32(b0[2], b0[3], A_hi, true);
                    int B_lo = __builtin_amdgcn_cvt_pk_fp8_f32(a1[0], a1[1], 0, false); B_lo = __builtin_amdgcn_cvt_pk_fp8_f32(a1[2], a1[3], B_lo, true);
                    int B_hi = __builtin_amdgcn_cvt_pk_fp8_f32(b1[0], b1[1], 0, false); B_hi = __builtin_amdgcn_cvt_pk_fp8_f32(b1[2], b1[3], B_hi, true);
                    const int r_lo = __shfl_xor(odd ? A_lo : B_lo, 16), r_hi = __shfl_xor(odd ? A_hi : B_hi, 16);
                    const u32x4 o = {(unsigned)(odd ? r_lo : A_lo), (unsigned)(odd ? r_hi : A_hi), (unsigned)(odd ? B_lo : r_lo), (unsigned)(odd ? B_hi : r_hi)};
                    if (sti >= 0) *(u32x4*)(YB + (size_t)sti * 1024 + pnl * 256 + bj * 128 + wc * 32 + 8 * (fq & 2)) = o;
                }
            }
    }
};
struct MoeOrder {
    const int* tile_e; int ntiles, npn, G, c; int lim;
    __device__ __forceinline__ bool next(int i, Unit& u) const {
        const int L = i * G + c; if (L >= lim) return false;
        const int tile = L / npn, pn = L - tile * npn; u.pm = tile; u.pn = tile_e[tile] * npn + pn; return true;
    }
    __device__ __forceinline__ void a_ready(const Unit&) const {}
    __device__ __forceinline__ void done(const Unit&) const {}
};
struct LateOrder {
    const int* tile_e; int ntiles, G, c, nlate, tile0; unsigned* cnt; unsigned* tmo;
    __device__ __forceinline__ bool next(int i, Unit& u) const {
        const int NL = G - nlate; int L;
        if (c < nlate) L = 2 * NL + i * G + c; else L = (i < 2) ? i * NL + (c - nlate) : 2 * NL + (i - 2) * G + c;
        if (L >= ntiles * 4) return false;
        const int tile = L >> 2, pn = L & 3; u.pm = tile; u.pn = tile_e[tile] * 4 + pn; return true;
    }
    __device__ __forceinline__ void a_ready(const Unit& u) const {
        if (u.pm < tile0) return;
        if (__builtin_amdgcn_readfirstlane((int)threadIdx.x >> 6) == 0) {
            unsigned* w = cnt + 64 * (u.pm - tile0); unsigned sp = 0u;
            while ((unsigned)__builtin_amdgcn_readfirstlane((int)__hip_atomic_load(w, __ATOMIC_RELAXED, __HIP_MEMORY_SCOPE_AGENT)) < 2u) {
                __builtin_amdgcn_s_sleep(2);
                if (++sp > (1u << 22)) { if ((threadIdx.x & 63) == 0) __hip_atomic_store(tmo, 1u, __ATOMIC_RELAXED, __HIP_MEMORY_SCOPE_AGENT); break; }
            }
            __builtin_amdgcn_fence(__ATOMIC_ACQUIRE, "agent");
        }
        asm volatile("s_waitcnt vmcnt(0) lgkmcnt(0)" ::: "memory"); __builtin_amdgcn_s_barrier(); asm volatile("" ::: "memory");
    }
    __device__ __forceinline__ void done(const Unit&) const {}
};
}

#ifndef SB_EARLY_EXIT
#define SB_EARLY_EXIT 1
#endif
#ifndef SB_EXIT_R
#define SB_EXIT_R 0x1p-40f
#endif
namespace att {
typedef __attribute__((address_space(3))) unsigned char l8;
typedef short bf16x8 __attribute__((ext_vector_type(8)));
typedef short s16x4 __attribute__((ext_vector_type(4)));
typedef float f32x16 __attribute__((ext_vector_type(16)));
typedef float f32x4 __attribute__((ext_vector_type(4)));
typedef unsigned u32x4 __attribute__((ext_vector_type(4)));
typedef unsigned short bf16_t;
constexpr int SLOT_K = 12288, SLOT_V = 8192;
constexpr int L_K = 0, L_V = 2 * SLOT_K, L_WS = L_V + 2 * SLOT_V, L_FLAG = L_WS + 8 * 256, L_OST = L_FLAG + 256, L_END = L_OST + 8 * 4096;
__device__ __forceinline__ int crow(int r, int hi) { return (r & 3) + 8 * (r >> 2) + 4 * hi; }
__device__ __forceinline__ void glds16(const void* gsrc, unsigned lds_dst) { unsigned keep;
    asm volatile("s_mov_b32 %0, m0\n\ts_mov_b32 m0, %2\n\ts_nop 0\n\tglobal_load_lds_dwordx4 %1, off\n\ts_mov_b32 m0, %0" : "=&s"(keep) : "v"(gsrc), "s"(lds_dst) : "memory"); }
__device__ __forceinline__ void glds16s(const void* sbase, unsigned voff, unsigned lds_dst) { unsigned keep;
    asm volatile("s_mov_b32 %0, m0\n\ts_mov_b32 m0, %3\n\ts_nop 4\n\tglobal_load_lds_dwordx4 %1, %2\n\ts_mov_b32 m0, %0" : "=&s"(keep) : "v"(voff), "s"(sbase), "s"(lds_dst) : "memory"); }
__device__ __forceinline__ unsigned cvtpk(float lo, float hi) { return pg8::cvt_pk_bf16(lo, hi); }
__device__ __forceinline__ s16x4 vtr(const l8* p) { typedef short v4i16_t __attribute__((ext_vector_type(4)));
    return __builtin_bit_cast(s16x4, __builtin_amdgcn_ds_read_tr16_b64_v4i16((__attribute__((address_space(3))) v4i16_t*)p)); }
__device__ __forceinline__ float bf2f(unsigned short b) { return __builtin_bit_cast(float, (unsigned)b << 16); }
#define ATT_WAIT_BAR() asm volatile("s_waitcnt vmcnt(0) lgkmcnt(0)\n\ts_barrier" ::: "memory")

struct Tensors { const bf16_t* Q; int qp, qh;
                 const bf16_t* K; int kp, kh;
                 const bf16_t* KR;
                 const bf16_t* V; int vp, vh;
                 bf16_t* O; int ocol;
                 float* OSS; int ossc; };

constexpr int SBS = 16384, SB_NS = 7, SB_AHEAD = 3, SB_FLAG = SB_NS * SBS, SB_OST = SB_FLAG + 64;
__device__ __forceinline__ void sb_unit(l8* shm, int bh, int qb, const Tensors& P, int& lo) {
    const int tid = threadIdx.x, lane = tid & 63, r32 = lane & 31, hi = lane >> 5; const int wid = __builtin_amdgcn_readfirstlane(tid >> 6);
    const int b = bh >> 3, h = bh & 7; const long rowbase = (long)b * SEQ; const int q0 = qb * 256, a = q0 + 32 * wid, J = q0 >> 6;
    const unsigned lds0 = (unsigned)(uintptr_t)shm;
    __attribute__((address_space(3))) unsigned* flg = (__attribute__((address_space(3))) unsigned*)(shm + SB_FLAG);
    const bf16_t* kbase = P.K + rowbase * P.kp + h * P.kh + wid * 8;
    const bf16_t* vbase = P.V + (rowbase + 16 * (wid & 3)) * P.vp + h * P.vh + (wid >> 2) * 32;
    const unsigned koff = (unsigned)(lane * P.kp * 2), voffl = (unsigned)(((lane >> 2) * P.vp + (lane & 3) * 8) * 2);
#define SB_DMA(t) do { const int sl_ = (t) % SB_NS; \
        glds16s(kbase + (long)(t) * 64 * P.kp, koff, (unsigned)__builtin_amdgcn_readfirstlane(lds0 + sl_ * SBS + wid * 1024)); \
        glds16s(vbase + (long)(t) * 64 * P.vp, voffl, (unsigned)__builtin_amdgcn_readfirstlane(lds0 + sl_ * SBS + 8192 + wid * 1024)); } while (0)
    if (lo < J - 3) lo = 1 << 20;
    { const int tl = (J - (SB_AHEAD - 1) > 0) ? J - (SB_AHEAD - 1) : 0;
      for (int t = (lo - 1 < J + 3 ? lo - 1 : J + 3); t >= tl; --t) SB_DMA(t);
      if (lo > tl) lo = tl; }
    if (lane < 2) flg[lane * 8 + wid] = 0u;
    bf16x8 qr[4];
    { const bf16_t* qw = P.Q + (rowbase + a + r32) * P.qp + h * P.qh + hi * 8;
#pragma unroll
      for (int c2 = 0; c2 < 4; ++c2) qr[c2] = *(const bf16x8*)(qw + c2 * 16); }
    asm volatile("s_waitcnt vmcnt(0)" ::: "memory");
#pragma unroll
    for (int c2 = 0; c2 < 4; ++c2) asm volatile("" : "+v"(qr[c2]));
    f32x16 o0 = {}, o1 = {};
    float R = 1.0f; bool done = false;
    const int vb = ((lane >> 4) & 1) * 32 + (lane & 3) * 8 + (4 * hi + ((lane & 15) >> 2)) * 64;
    int tw = J + (wid >> 1);
    for (int it = 0; it < J + 4; ++it, --tw) {
        ATT_WAIT_BAR();
        if (SB_EARLY_EXIT && it > 0) {
            const __attribute__((address_space(3))) unsigned* f = flg + ((it - 1) & 1) * 8;
            const unsigned all = f[0] & f[1] & f[2] & f[3] & f[4] & f[5] & f[6] & f[7];
            if (__builtin_amdgcn_readfirstlane(all) != 0u) break;
        }
        if (J - it - SB_AHEAD >= 0 && J - it - SB_AHEAD < lo) { SB_DMA(J - it - SB_AHEAD); lo = J - it - SB_AHEAD; }
        if (tw < 0) done = true;
        if (!done) {
            const int sl = tw % SB_NS;
            const l8* ks = shm + sl * SBS + hi * 1024 + r32 * 16;
            f32x16 p0 = {}, p1 = {};
#pragma unroll
            for (int c2 = 0; c2 < 4; ++c2) {
                const bf16x8 k0 = *(const __attribute__((address_space(3))) bf16x8*)(ks + c2 * 2048), k1 = *(const __attribute__((address_space(3))) bf16x8*)(ks + c2 * 2048 + 512);
                p0 = __builtin_amdgcn_mfma_f32_32x32x16_bf16(k0, qr[c2], p0, 0, 0, 0);
                p1 = __builtin_amdgcn_mfma_f32_32x32x16_bf16(k1, qr[c2], p1, 0, 0, 0);
            }
            if (it == 0) {
                const int tqh = a + r32 - 64 * tw - 1 - 4 * hi;
#pragma unroll
                for (int r = 0; r < 16; ++r) { const int kc = (r & 3) + 8 * (r >> 2); if (kc > tqh) p0[r] = -INFINITY; if (kc + 32 > tqh) p1[r] = -INFINITY; }
            }
            unsigned pw[16];
            float bt0[16], bt1[16];
#pragma unroll
            for (int r = 0; r < 16; ++r) {
                const float e0 = __builtin_amdgcn_exp2f(fminf(p0[r], 100.f)), e1 = __builtin_amdgcn_exp2f(fminf(p1[r], 100.f));
                const float i0 = __builtin_amdgcn_rcpf(1.0f + e0), i1 = __builtin_amdgcn_rcpf(1.0f + e1);
                p0[r] = i0; p1[r] = i1; bt0[r] = e0 * i0; bt1[r] = e1 * i1;
            }
            float RE = R;
#pragma unroll
            for (int g = 7; g >= 0; --g) {
                float r0, r1, r2, r3, b0, b1, b2, b3;
                if (g >= 4) { r0 = p1[4 * (g - 4)]; r1 = p1[4 * (g - 4) + 1]; r2 = p1[4 * (g - 4) + 2]; r3 = p1[4 * (g - 4) + 3]; b0 = bt1[4 * (g - 4)]; b1 = bt1[4 * (g - 4) + 1]; b2 = bt1[4 * (g - 4) + 2]; b3 = bt1[4 * (g - 4) + 3]; }
                else { r0 = p0[4 * g]; r1 = p0[4 * g + 1]; r2 = p0[4 * g + 2]; r3 = p0[4 * g + 3]; b0 = bt0[4 * g]; b1 = bt0[4 * g + 1]; b2 = bt0[4 * g + 2]; b3 = bt0[4 * g + 3]; }
                const float w2 = r3, w1 = w2 * r2, w0 = w1 * r1, G = w0 * r0;
                auto sw = __builtin_amdgcn_permlane32_swap(__float_as_uint(G), __float_as_uint(G), false, false);
                const float g0 = __uint_as_float(sw[0]), g1 = __uint_as_float(sw[1]);
                const float Mx = RE * (hi ? 1.0f : g1);
                const float a3 = b3 * Mx, a2 = b2 * w2 * Mx, a1 = b1 * w1 * Mx, a0 = b0 * w0 * Mx;
                pw[2 * g] = cvtpk(a0, a1); pw[2 * g + 1] = cvtpk(a2, a3);
                RE *= g0 * g1;
            }
            R = RE;
            if (SB_EARLY_EXIT) done = __all(R < SB_EXIT_R);
            const l8* vs = shm + sl * SBS + 8192 + vb;
#pragma unroll
            for (int ks2 = 0; ks2 < 4; ++ks2) {
                const bf16x8 pa = __builtin_bit_cast(bf16x8, (u32x4){pw[4 * ks2], pw[4 * ks2 + 1], pw[4 * ks2 + 2], pw[4 * ks2 + 3]});
                { const s16x4 lo_ = vtr(vs + ks2 * 1024), hh = vtr(vs + ks2 * 1024 + 512);
                  o0 = __builtin_amdgcn_mfma_f32_32x32x16_bf16(pa, (bf16x8){lo_[0], lo_[1], lo_[2], lo_[3], hh[0], hh[1], hh[2], hh[3]}, o0, 0, 0, 0); }
                { const s16x4 lo_ = vtr(vs + 4096 + ks2 * 1024), hh = vtr(vs + 4096 + ks2 * 1024 + 512);
                  o1 = __builtin_amdgcn_mfma_f32_32x32x16_bf16(pa, (bf16x8){lo_[0], lo_[1], lo_[2], lo_[3], hh[0], hh[1], hh[2], hh[3]}, o1, 0, 0, 0); }
            }
        }
        if (lane == 0) flg[(it & 1) * 8 + wid] = done ? 1u : 0u;
    }
    int lane_e = lane; asm volatile("" : "+v"(lane_e));
    const int r32e = lane_e & 31, hie = lane_e >> 5;
    { __attribute__((address_space(3))) bf16_t* stg = (__attribute__((address_space(3))) bf16_t*)(shm + SB_OST) + wid * 1024;
      bf16_t* ow = P.O + (rowbase + a) * 1024 + P.ocol + h * 64;
      float sq[2] = {0.f, 0.f};
#pragma unroll
      for (int dh = 0; dh < 2; ++dh) {
#pragma unroll
          for (int r = 0; r < 16; ++r) stg[crow(r, hie) * 32 + r32e] = (bf16_t)(cvtpk(dh ? o1[r] : o0[r], 0.f) & 0xffffu);
          asm volatile("s_waitcnt lgkmcnt(0)" ::: "memory");
#pragma unroll
          for (int i = 0; i < 2; ++i) { const int row = i * 16 + (lane_e >> 2), ch = lane_e & 3;
              const u32x4 v = *(const __attribute__((address_space(3))) u32x4*)(stg + row * 32 + ch * 8);
              *(u32x4*)(ow + (long)row * 1024 + dh * 32 + ch * 8) = v;
#pragma unroll
              for (int e = 0; e < 4; ++e) { const float x0 = __builtin_bit_cast(float, v[e] << 16), x1 = __builtin_bit_cast(float, v[e] & 0xffff0000u); sq[i] += x0 * x0 + x1 * x1; } }
          asm volatile("s_waitcnt lgkmcnt(0)" ::: "memory");
      }
#pragma unroll
      for (int i = 0; i < 2; ++i) { float s_ = sq[i]; s_ += __shfl_xor(s_, 1); s_ += __shfl_xor(s_, 2);
          if ((lane_e & 3) == 0) P.OSS[(rowbase + a + i * 16 + (lane_e >> 2)) * 16 + P.ossc + h] = s_; } }
    ATT_WAIT_BAR();
#undef SB_DMA
}
template <int MODE>
__device__ __forceinline__ void attn_unit(l8* shm, int bh, int qb, const Tensors& P, const bool pre, const bool nxt) {
    constexpr int NC2 = MODE ? 6 : 4;
    const int tid = threadIdx.x, lane = tid & 63, r32 = lane & 31, hi = lane >> 5; const int wid = __builtin_amdgcn_readfirstlane(tid >> 6);
    const int b = bh >> 3, h = bh & 7; const long rowbase = (long)b * SEQ; const int q0 = qb * 512, a = q0 + 64 * wid;
    const unsigned lds0 = (unsigned)(uintptr_t)shm;
    __attribute__((address_space(3))) float* wsf = (__attribute__((address_space(3))) float*)(shm + L_WS) + wid * 64;
    __attribute__((address_space(3))) unsigned* flg = (__attribute__((address_space(3))) unsigned*)(shm + L_FLAG);
    const int NT = (q0 + 512) / 64;
    const bf16_t* kbase = P.K + rowbase * P.kp + h * P.kh + wid * 8;
    const bf16_t* krbase = MODE ? P.KR + rowbase * ROPE + (wid & 3) * 8 : nullptr;
    const bf16_t* vbase = P.V + (rowbase + 16 * (wid & 3)) * P.vp + h * P.vh + (wid >> 2) * 32;
    const unsigned koff = (unsigned)(lane * P.kp * 2), kroff = (unsigned)(lane * ROPE * 2), voffl = (unsigned)(((lane >> 2) * P.vp + (lane & 3) * 8) * 2);
#define ATT_DMA(j, s) do { \
        glds16s(kbase + (long)(j) * 64 * P.kp, koff, (unsigned)__builtin_amdgcn_readfirstlane(lds0 + L_K + (s) * SLOT_K + wid * 1024)); \
        if (MODE && wid < 4) glds16s(krbase + (long)(j) * 64 * ROPE, kroff, (unsigned)__builtin_amdgcn_readfirstlane(lds0 + L_K + (s) * SLOT_K + (8 + wid) * 1024)); \
        glds16s(vbase + (long)(j) * 64 * P.vp, voffl, (unsigned)__builtin_amdgcn_readfirstlane(lds0 + L_V + (s) * SLOT_V + wid * 1024)); } while (0)
    if (!pre) ATT_DMA(NT - 1, 0);
    if (lane < 2) flg[lane * 8 + wid] = 0u;
    bf16x8 qr[2][NC2];
#pragma unroll
    for (int z = 0; z < 2; ++z) { const bf16_t* qw = P.Q + (rowbase + a + 32 * z + r32) * P.qp + h * P.qh + hi * 8;
#pragma unroll
        for (int c2 = 0; c2 < NC2; ++c2) qr[z][c2] = *(const bf16x8*)(qw + c2 * 16); }
    asm volatile("s_waitcnt vmcnt(0)" ::: "memory");
#pragma unroll
    for (int z = 0; z < 2; ++z)
#pragma unroll
        for (int c2 = 0; c2 < NC2; ++c2) asm volatile("" : "+v"(qr[z][c2]));
    f32x16 o0[2] = {{}, {}}, o1[2] = {{}, {}};
    float m_run[2] = {-1e30f, -1e30f}, l_run[2] = {0.f, 0.f}, R[2] = {1.0f, 1.0f}; bool done = false;
    const int vb = ((lane >> 4) & 1) * 32 + (lane & 3) * 8 + (4 * hi + ((lane & 15) >> 2)) * 64;
    for (int it = 0; it < NT; ++it) {
        const int j = NT - 1 - it, s = it & 1;
        ATT_WAIT_BAR();
        if (MODE == 0 && SB_EARLY_EXIT && it > 0) {
            const __attribute__((address_space(3))) unsigned* f = flg + ((it - 1) & 1) * 8;
            unsigned all = f[0] & f[1] & f[2] & f[3] & f[4] & f[5] & f[6] & f[7];
            if (__builtin_amdgcn_readfirstlane(all) != 0u) { if (nxt) ATT_DMA(NT - 9, 0); break; }
        }
        if (it + 1 < NT) ATT_DMA(j - 1, s ^ 1); else if (nxt) ATT_DMA(NT - 9, 0);
        if (64 * j <= a && !done) {
            const l8* ks = shm + L_K + s * SLOT_K + hi * 1024 + r32 * 16;
            f32x16 p0[2] = {{}, {}}, p1[2] = {{}, {}};
#pragma unroll
            for (int c2 = 0; c2 < NC2; ++c2) {
                const bf16x8 k0 = *(const __attribute__((address_space(3))) bf16x8*)(ks + c2 * 2048), k1 = *(const __attribute__((address_space(3))) bf16x8*)(ks + c2 * 2048 + 512);
#pragma unroll
                for (int z = 0; z < 2; ++z) { p0[z] = __builtin_amdgcn_mfma_f32_32x32x16_bf16(k0, qr[z][c2], p0[z], 0, 0, 0); p1[z] = __builtin_amdgcn_mfma_f32_32x32x16_bf16(k1, qr[z][c2], p1[z], 0, 0, 0); }
            }
            if (64 * j == a) {
#pragma unroll
                for (int z = 0; z < 2; ++z) { const int tqh = 32 * z + r32 - (MODE ? 0 : 1) - 4 * hi;
#pragma unroll
                    for (int r = 0; r < 16; ++r) { const int kc = (r & 3) + 8 * (r >> 2); if (kc > tqh) p0[z][r] = -INFINITY; if (kc + 32 > tqh) p1[z][r] = -INFINITY; } }
            }
            unsigned pw[2][16];
#pragma unroll
            for (int z = 0; z < 2; ++z) {
              if (MODE == 1) {
                float rm = fmaxf(p0[z][0], p1[z][0]);
#pragma unroll
                for (int r = 1; r < 16; ++r) rm = fmaxf(fmaxf(rm, p0[z][r]), p1[z][r]);
                { auto rr = __builtin_amdgcn_permlane32_swap(__float_as_uint(rm), __float_as_uint(rm), false, false); rm = fmaxf(__uint_as_float(rr[0]), __uint_as_float(rr[1])); }
                if (__any(rm > m_run[z] + 8.0f)) {
                    const float mn = fmaxf(m_run[z], rm), alpha = __builtin_amdgcn_exp2f(m_run[z] - mn); m_run[z] = mn; l_run[z] *= alpha;
                    if (hi == 0) wsf[32 * z + r32] = alpha;
#pragma unroll
                    for (int g = 0; g < 4; ++g) { const f32x4 al = *(const __attribute__((address_space(3))) f32x4*)(wsf + 32 * z + 8 * g + 4 * hi);
#pragma unroll
                        for (int i = 0; i < 4; ++i) { o0[z][4 * g + i] *= al[i]; o1[z][4 * g + i] *= al[i]; } }
                }
                float ls = 0.f;
#pragma unroll
                for (int r = 0; r < 16; ++r) { p0[z][r] = __builtin_amdgcn_exp2f(p0[z][r] - m_run[z]); p1[z][r] = __builtin_amdgcn_exp2f(p1[z][r] - m_run[z]); ls += p0[z][r] + p1[z][r]; }
                l_run[z] += ls;
#pragma unroll
                for (int r = 0; r < 8; ++r) { pw[z][r] = cvtpk(p0[z][2 * r], p0[z][2 * r + 1]); pw[z][8 + r] = cvtpk(p1[z][2 * r], p1[z][2 * r + 1]); }
              } else {
                float bt0[16], bt1[16];
#pragma unroll
                for (int r = 0; r < 16; ++r) {
                    const float e0 = __builtin_amdgcn_exp2f(fminf(p0[z][r], 100.f)), e1 = __builtin_amdgcn_exp2f(fminf(p1[z][r], 100.f));
                    const float i0 = __builtin_amdgcn_rcpf(1.0f + e0), i1 = __builtin_amdgcn_rcpf(1.0f + e1);
                    p0[z][r] = i0; p1[z][r] = i1; bt0[r] = e0 * i0; bt1[r] = e1 * i1;
                }
                float RE = R[z];
#pragma unroll
                for (int g = 7; g >= 0; --g) {
                    float r0, r1, r2, r3, b0, b1, b2, b3;
                    if (g >= 4) { r0 = p1[z][4 * (g - 4)]; r1 = p1[z][4 * (g - 4) + 1]; r2 = p1[z][4 * (g - 4) + 2]; r3 = p1[z][4 * (g - 4) + 3]; b0 = bt1[4 * (g - 4)]; b1 = bt1[4 * (g - 4) + 1]; b2 = bt1[4 * (g - 4) + 2]; b3 = bt1[4 * (g - 4) + 3]; }
                    else { r0 = p0[z][4 * g]; r1 = p0[z][4 * g + 1]; r2 = p0[z][4 * g + 2]; r3 = p0[z][4 * g + 3]; b0 = bt0[4 * g]; b1 = bt0[4 * g + 1]; b2 = bt0[4 * g + 2]; b3 = bt0[4 * g + 3]; }
                    const float w2 = r3, w1 = w2 * r2, w0 = w1 * r1, G = w0 * r0;
                    auto sw = __builtin_amdgcn_permlane32_swap(__float_as_uint(G), __float_as_uint(G), false, false);
                    const float g0 = __uint_as_float(sw[0]), g1 = __uint_as_float(sw[1]);
                    const float Mx = RE * (hi ? 1.0f : g1);
                    const float a3 = b3 * Mx, a2 = b2 * w2 * Mx, a1 = b1 * w1 * Mx, a0 = b0 * w0 * Mx;
                    pw[z][2 * g] = cvtpk(a0, a1); pw[z][2 * g + 1] = cvtpk(a2, a3);
                    RE *= g0 * g1;
                }
                R[z] = RE;
              }
            }
            if (MODE == 0 && SB_EARLY_EXIT) done = __all(fmaxf(R[0], R[1]) < SB_EXIT_R);
            const l8* vs = shm + L_V + s * SLOT_V + vb;
#pragma unroll
            for (int ks2 = 0; ks2 < 4; ++ks2) {
                bf16x8 vf0, vf1;
                { const s16x4 lo = vtr(vs + ks2 * 1024), hh = vtr(vs + ks2 * 1024 + 512); vf0 = (bf16x8){lo[0], lo[1], lo[2], lo[3], hh[0], hh[1], hh[2], hh[3]}; }
                { const s16x4 lo = vtr(vs + 4096 + ks2 * 1024), hh = vtr(vs + 4096 + ks2 * 1024 + 512); vf1 = (bf16x8){lo[0], lo[1], lo[2], lo[3], hh[0], hh[1], hh[2], hh[3]}; }
#pragma unroll
                for (int z = 0; z < 2; ++z) {
                    const bf16x8 pa = __builtin_bit_cast(bf16x8, (u32x4){pw[z][4 * ks2], pw[z][4 * ks2 + 1], pw[z][4 * ks2 + 2], pw[z][4 * ks2 + 3]});
                    o0[z] = __builtin_amdgcn_mfma_f32_32x32x16_bf16(pa, vf0, o0[z], 0, 0, 0);
                    o1[z] = __builtin_amdgcn_mfma_f32_32x32x16_bf16(pa, vf1, o1[z], 0, 0, 0);
                }
            }
        }
        if (MODE == 0 && SB_EARLY_EXIT) { if (lane == 0) flg[s * 8 + wid] = done ? 1u : 0u; }
    }
    int lane_e = lane; asm volatile("" : "+v"(lane_e));
    const int r32e = lane_e & 31, hie = lane_e >> 5;
#pragma unroll
    for (int z = 0; z < 2; ++z) {
        if (MODE == 1) {
            float l = l_run[z];
            { auto rr = __builtin_amdgcn_permlane32_swap(__float_as_uint(l), __float_as_uint(l), false, false); l = __uint_as_float(rr[0]) + __uint_as_float(rr[1]); }
            if (hie == 0) wsf[r32e] = __builtin_amdgcn_rcpf(l);
#pragma unroll
            for (int g = 0; g < 4; ++g) { const f32x4 il = *(const __attribute__((address_space(3))) f32x4*)(wsf + 8 * g + 4 * hie);
#pragma unroll
                for (int i = 0; i < 4; ++i) { o0[z][4 * g + i] *= il[i]; o1[z][4 * g + i] *= il[i]; } }
        }
        __attribute__((address_space(3))) bf16_t* stg = (__attribute__((address_space(3))) bf16_t*)(shm + L_OST) + wid * 2048;
#pragma unroll
        for (int r = 0; r < 16; ++r) { const int orow = crow(r, hie);
            stg[orow * 64 + r32e] = (bf16_t)(cvtpk(o0[z][r], 0.f) & 0xffffu); stg[orow * 64 + 32 + r32e] = (bf16_t)(cvtpk(o1[z][r], 0.f) & 0xffffu); }
        asm volatile("s_waitcnt lgkmcnt(0)" ::: "memory");
        bf16_t* ow = P.O + (rowbase + a + 32 * z) * 1024 + P.ocol + h * 64;
#pragma unroll
        for (int i = 0; i < 4; ++i) { const int row = i * 8 + (lane_e >> 3), ch = lane_e & 7;
            const u32x4 v = *(const __attribute__((address_space(3))) u32x4*)(stg + row * 64 + ch * 8);
            *(u32x4*)(ow + (long)row * 1024 + ch * 8) = v;
            float sq = 0.f;
#pragma unroll
            for (int e = 0; e < 4; ++e) { const float x0 = __builtin_bit_cast(float, v[e] << 16), x1 = __builtin_bit_cast(float, v[e] & 0xffff0000u); sq += x0 * x0 + x1 * x1; }
            sq += __shfl_xor(sq, 1); sq += __shfl_xor(sq, 2); sq += __shfl_xor(sq, 4);
            if (ch == 0) P.OSS[(rowbase + a + 32 * z + row) * 16 + P.ossc + h] = sq; }
        asm volatile("s_waitcnt lgkmcnt(0)" ::: "memory");
    }
    ATT_WAIT_BAR();
#undef ATT_DMA
}
}

__device__ __forceinline__ float wave_sum(float v) {
#pragma unroll
    for (int o = 1; o < 64; o <<= 1) v += __shfl_xor(v, o);
    return v;
}
__device__ __forceinline__ float bflo(unsigned w) { return __builtin_bit_cast(float, w << 16); }
__device__ __forceinline__ float bfhi(unsigned w) { return __builtin_bit_cast(float, w & 0xffff0000u); }

template <class V> __device__ __forceinline__ void tr_load(const V& val, int nblk, int item, int lane, float (&tv)[32]) {
    const int kb = item / nblk, nb = item - kb * nblk, k0 = 64 * kb, n0 = 32 * nb;
#pragma unroll
    for (int i = 0; i < 32; ++i) tv[i] = val(k0 + 2 * i + (lane >> 5), n0 + (lane & 31));
}
__device__ __forceinline__ void tr_store(const float (&tv)[32], int K, int nblk, bf16* WT, LAS float* scr, int item, int lane) {
    const int kb = item / nblk, nb = item - kb * nblk, k0 = 64 * kb, n0 = 32 * nb;
#pragma unroll
    for (int i = 0; i < 32; ++i) scr[(2 * i + (lane >> 5)) * 33 + (lane & 31)] = tv[i];
    LDS_WAIT(); asm volatile("" ::: "memory");
    const int c = lane & 7;
#pragma unroll
    for (int j = 0; j < 4; ++j) { const int n = (lane >> 3) + 8 * j; const LAS float* s = scr + (8 * c) * 33 + n;
        v4u o; o.x = pk2(s[0 * 33], s[1 * 33]); o.y = pk2(s[2 * 33], s[3 * 33]); o.z = pk2(s[4 * 33], s[5 * 33]); o.w = pk2(s[6 * 33], s[7 * 33]);
        *(GAS v4u*)(WT + (size_t)(n0 + n) * K + k0 + 8 * c) = o; }
    LDS_WAIT(); asm volatile("" ::: "memory");
}
template <class V> __device__ __forceinline__ void tr_load4(const V& val, int nblk, int item, int lane, f32x4 (&tv)[8]) {
    const int kb = item / nblk, nb = item - kb * nblk, k0 = 64 * kb, n0 = 32 * nb;
#pragma unroll
    for (int i = 0; i < 8; ++i) tv[i] = val.v4(k0 + 8 * i + (lane >> 3), n0 + 4 * (lane & 7));
}
__device__ __forceinline__ void tr_store4(const f32x4 (&tv)[8], int K, int nblk, bf16* WT, LAS float* scr, int item, int lane) {
    const int kb = item / nblk, nb = item - kb * nblk, k0 = 64 * kb, n0 = 32 * nb;
#pragma unroll
    for (int i = 0; i < 8; ++i) { LAS float* d = scr + (8 * i + (lane >> 3)) * 33 + 4 * (lane & 7); d[0] = tv[i].x; d[1] = tv[i].y; d[2] = tv[i].z; d[3] = tv[i].w; }
    LDS_WAIT(); asm volatile("" ::: "memory");
    const int c = lane & 7;
#pragma unroll
    for (int j = 0; j < 4; ++j) { const int n = (lane >> 3) + 8 * j; const LAS float* s = scr + (8 * c) * 33 + n;
        v4u o; o.x = pk2(s[0 * 33], s[1 * 33]); o.y = pk2(s[2 * 33], s[3 * 33]); o.z = pk2(s[4 * 33], s[5 * 33]); o.w = pk2(s[6 * 33], s[7 * 33]);
        *(GAS v4u*)(WT + (size_t)(n0 + n) * K + k0 + 8 * c) = o; }
    LDS_WAIT(); asm volatile("" ::: "memory");
}
struct XwSrc { uintptr_t wg; long long dlt  ; uintptr_t wd, g, WGU, WD; };
constexpr int XW_GU1 = 16 * 16, XW_GU = NEXP * XW_GU1, XW_D1 = 4 * 32, XW_D = NEXP * XW_D1, XW_NI = XW_GU + XW_D;
__device__ __forceinline__ void xw_load(const XwSrc& S, int r, int lane, f32x4 (&tv)[8], float (&gk)[8]) {
    const bool gu = r < XW_GU; const int rr = gu ? r : r - XW_GU; const int e = gu ? (rr >> 8) : (rr >> 7); const int li = gu ? (rr & 255) : (rr & 127);
    const int kb = gu ? (li >> 4) : (li >> 5), nb = gu ? (li & 15) : (li & 31); const int k = 64 * kb + (lane >> 3), n = 32 * nb + 4 * (lane & 7);
    const uintptr_t bgu = S.wg + (uintptr_t)(((n >> 2) & 1) * S.dlt), base = (gu ? bgu : S.wd) + (uintptr_t)e * (DM * DEXP * 4);
    const int pitch = gu ? DEXP : DM; const int col = gu ? 4 * (n >> 3) : n;
    const GAS float* p = (const GAS float*)base + (size_t)k * pitch + col; const GAS float* gp = (const GAS float*)S.g + (gu ? k : (lane >> 3));
#pragma unroll
    for (int i = 0; i < 8; ++i) { tv[i] = *(const GAS f32x4*)(p + (size_t)(8 * i) * pitch); gk[i] = gp[8 * i]; }
}
__device__ __forceinline__ void xw_store(const XwSrc& S, int r, int lane, LAS float* scr, const f32x4 (&tv)[8], const float (&gk)[8]) {
    const bool gu = r < XW_GU; const int rr = gu ? r : r - XW_GU; const int e = gu ? (rr >> 8) : (rr >> 7); const int li = gu ? (rr & 255) : (rr & 127);
    const int kb = gu ? (li >> 4) : (li >> 5), nb = gu ? (li & 15) : (li & 31); const int k0 = 64 * kb, n0 = 32 * nb; const int K = gu ? DM : DEXP;
    bf16* WT = (bf16*)((gu ? S.WGU : S.WD) + (uintptr_t)e * (gu ? 512 * 1024 * 2 : 1024 * 256 * 2));
#pragma unroll
    for (int i = 0; i < 8; ++i) { const float gm = gu ? gk[i] : 1.0f; LAS float* d = scr + (8 * i + (lane >> 3)) * 33 + 4 * (lane & 7); d[0] = tv[i].x * gm; d[1] = tv[i].y * gm; d[2] = tv[i].z * gm; d[3] = tv[i].w * gm; }
    LDS_WAIT(); asm volatile("" ::: "memory");
    const int c = lane & 7;
#pragma unroll
    for (int j = 0; j < 4; ++j) { const int n = (lane >> 3) + 8 * j; const LAS float* s = scr + (8 * c) * 33 + n;
        v4u o; o.x = pk2(s[0 * 33], s[1 * 33]); o.y = pk2(s[2 * 33], s[3 * 33]); o.z = pk2(s[4 * 33], s[5 * 33]); o.w = pk2(s[6 * 33], s[7 * 33]);
        *(GAS v4u*)(WT + (size_t)(n0 + n) * K + k0 + 8 * c) = o; }
    LDS_WAIT(); asm volatile("" ::: "memory");
}
template <class V> __device__ __forceinline__ void tr_item(const V& val, int K, int nblk, bf16* WT, LAS float* scr, int item, int lane) {
    float tv[32]; tr_load(val, nblk, item, lane, tv); tr_store(tv, K, nblk, WT, scr, item, lane);
}
struct VWin { const float* w; __device__ __forceinline__ float operator()(int k, int n) const {
    if (n >= INC) return 0.f; const int i = n - 1920; const int src = (i < 0) ? n : 1920 + (i >> 1) + 16 * (i & 1); return w[(size_t)k * INC + src]; } };
struct VWuq { const float* w; const float* g; __device__ __forceinline__ float operator()(int k, int n) const {
    const int h = n / QKD, j = n - h * QKD, i = j - NOPE; const int src = (i < 0) ? n : h * QKD + NOPE + (i >> 1) + 16 * (i & 1); return w[(size_t)k * 768 + src] * g[k]; } };
struct VWukv { const float* w; const float* g; __device__ __forceinline__ float operator()(int k, int n) const { return k < KVLORA ? w[(size_t)k * 1024 + n] * g[k] : 0.f; } };
struct VWout { const float* w; const float* gs; const float* gm; __device__ __forceinline__ float operator()(int k, int n) const { return w[(size_t)k * 1024 + n] * (k < SBW ? gs[k] : gm[k - SBW]); } };
struct VWr { const float* wg; const float* we; const float* g; __device__ __forceinline__ float operator()(int k, int n) const {
    if (n < NGRP) return wg[(size_t)k * NGRP + n] * g[k]; if (n >= 128 && n < 128 + NEXP) return we[(size_t)k * NEXP + (n - 128)] * g[k]; return 0.f; } };
struct VWgu { const float* wgt; long long dlt  ; const float* g; __device__ __forceinline__ float operator()(int k, int n) const {
    const int hc = 4 * (n >> 3) + (n & 3); const float* w = (const float*)((uintptr_t)wgt + (uintptr_t)(((n >> 2) & 1) * dlt)); return w[(size_t)k * DEXP + hc] * g[k]; }
    __device__ __forceinline__ f32x4 v4(int k, int n) const {
        const float* w = (const float*)((uintptr_t)wgt + (uintptr_t)(((n >> 2) & 1) * dlt)); return *(const GAS f32x4*)(w + (size_t)k * DEXP + 4 * (n >> 3)) * g[k]; } };
struct VWd { const float* w; __device__ __forceinline__ float operator()(int k, int n) const { return w[(size_t)k * DM + n]; }
    __device__ __forceinline__ f32x4 v4(int k, int n) const { return *(const GAS f32x4*)(w + (size_t)k * DM + n); } };

struct Args { const void* in[20]; float* out; unsigned char* ws; int ph_lo, ph_hi, pad0, pad1; };
constexpr int NPHASE = 12;
__global__ void __launch_bounds__(NWAVES * 64, 2) fwd_kernel(Args args) {
    extern __shared__ __attribute__((aligned(16))) unsigned char lds_raw[];
    LAS unsigned char* lds = (LAS unsigned char*)lds_raw;
    volatile LAS unsigned* MISC = (volatile LAS unsigned*)(lds + MISC_OFF);
    const int tid = threadIdx.x, lane = tid & 63, wave = __builtin_amdgcn_readfirstlane(tid >> 6);
    const int G = gridDim.x, bx = blockIdx.x;
    const __attribute__((address_space(4))) Args* KA = (const __attribute__((address_space(4))) Args*)__builtin_amdgcn_kernarg_segment_ptr();
#define FIN(i) ((const float*)KA->in[i])
#define WSP(TY, off) ((TY*)(KA->ws + (off)))
    gu32* ctl = (gu32*)WSP(unsigned char, WS_CTL);
    for (int u = tid; u < (LDS_BYTES - LDSCTL_OFF) / 4; u += NWAVES * 64) ((LAS unsigned*)(lds + LDSCTL_OFF))[u] = 0u;
    __syncthreads();
    const int lo = KA->ph_lo, hi = KA->ph_hi;
    const bool use_bar = (hi - lo) > 1;
    XcdBarrier bar; bar.bar = (unsigned*)(ctl + CW_BAR); bar.x = 0; bar.st = nullptr;
    if (use_bar) bar = xcd_barrier_post((unsigned*)(ctl + CW_BAR), MISC + 8);
#ifndef PH_MASK
#define PH_MASK 0xfff
#endif
#define IN(k) ((((PH_MASK) >> (k)) & 1) && lo <= (k) && (k) < hi)
#ifndef PROBE_PHASE
#define PROBE_PHASE -1
#endif
#ifndef ATT_SEL
#define ATT_SEL 3
#endif
#define REP(k) for (int rep_ = 0; rep_ < ((PROBE_PHASE) == (k) ? 2 : 1); ++rep_)
#define SEAM(k) do { if (IN(k) && IN((k) + 1)) xcd_barrier(bar); } while (0)
    const int gw = bx * NWAVES + wave, NGW = G * NWAVES;

    if (IN(0)) REP(0) {
        LAS float* scr = (LAS float*)(lds + RING_OFF + wave * 16384);
        constexpr int I_WIN = 16 * 64, I_WUQ = 4 * 24, I_WUKV = 2 * 32, I_WOUT = 16 * 32, I_WR = 16 * 8;
        constexpr int NITEMS = I_WIN + I_WUQ + I_WUKV + I_WOUT + I_WR;
        for (int it = gw; it < NITEMS; it += NGW) {
            int r = it;
            if (r < I_WIN) { tr_item(VWin{FIN(3)}, 1024, 64, WSP(bf16, WS_WIN), scr, r, lane); continue; } r -= I_WIN;
            if (r < I_WUQ) { tr_item(VWuq{FIN(5), FIN(4)}, 256, 24, WSP(bf16, WS_WUQ), scr, r, lane); continue; } r -= I_WUQ;
            if (r < I_WUKV) { tr_item(VWukv{FIN(7), FIN(6)}, 128, 32, WSP(bf16, WS_WUKV), scr, r, lane); continue; } r -= I_WUKV;
            if (r < I_WOUT) { tr_item(VWout{FIN(10), FIN(8), FIN(9)}, 1024, 32, WSP(bf16, WS_WOUT), scr, r, lane); continue; } r -= I_WOUT;
            tr_item(VWr{FIN(12), FIN(14), FIN(11)}, 1024, 8, WSP(bf16, WS_WR), scr, r, lane);
        }
        { const float* x = FIN(0); bf16* H = WSP(bf16, WS_H); float* INV1 = WSP(float, WS_INV1); f32x4 gn[4];
#pragma unroll
          for (int j = 0; j < 4; ++j) gn[j] = *((const GAS f32x4*)FIN(2) + lane + 64 * j);
          for (int m = gw; m < T; m += 4 * NGW) {
              f32x4 v[4][4]; float s2[4];
#pragma unroll
              for (int r = 0; r < 4; ++r) { const GAS f32x4* xr = (const GAS f32x4*)(x + (size_t)(m + r * NGW) * DM) + lane;
#pragma unroll
                  for (int j = 0; j < 4; ++j) v[r][j] = __builtin_nontemporal_load(xr + 64 * j); }
#pragma unroll
              for (int r = 0; r < 4; ++r) { float s = 0.f;
#pragma unroll
                  for (int j = 0; j < 4; ++j) s += (v[r][j].x * v[r][j].x + v[r][j].y * v[r][j].y) + (v[r][j].z * v[r][j].z + v[r][j].w * v[r][j].w);
                  s2[r] = s; }
#pragma unroll
              for (int o = 1; o < 64; o <<= 1) {
#pragma unroll
                  for (int r = 0; r < 4; ++r) s2[r] += __shfl_xor(s2[r], o); }
#pragma unroll
              for (int r = 0; r < 4; ++r) { const float var = s2[r] * (1.f / DM) + EPS; const float rstd = rsqrtf(var); if (lane == 0) INV1[m + r * NGW] = sqrtf(var);
                  GAS unsigned long long* o8 = (GAS unsigned long long*)(H + (size_t)(m + r * NGW) * DM) + lane;
#pragma unroll
                  for (int j = 0; j < 4; ++j) { const f32x4 y = v[r][j] * rstd * gn[j]; o8[64 * j] = (unsigned long long)pg8::cvt_pk_bf16(y.x, y.y) | ((unsigned long long)pg8::cvt_pk_bf16(y.z, y.w) << 32); } }
          } }
        { const int* positions = (const int*)KA->in[1]; unsigned* TAB = WSP(unsigned, WS_TAB);
          for (int idx = bx * (NWAVES * 64) + tid; idx < T * 16; idx += G * NWAVES * 64) {
            const int tok = idx >> 4, i = idx & 15;
            const double invd = ((i & 1) ? 0.56234132519034908039 : 1.0) * ((i & 2) ? 0.31622776601683793320 : 1.0) * ((i & 4) ? 0.1 : 1.0) * ((i & 8) ? 0.01 : 1.0);
            const double ang = (double)positions[tok] * invd;
            const double kq = rint(ang * 0.63661977236758134308);
            const double rr = fma(-kq, 1.57079632679489661923, ang) - kq * 6.123233995736766e-17;
            const float r = (float)rr, r2 = r * r;
            const float sn = r + r * r2 * (-1.6666667163e-01f + r2 * (8.3333337680e-03f + r2 * (-1.9841270114e-04f + r2 * 2.7557314297e-06f)));
            const float cs = 1.0f + r2 * (-0.5f + r2 * (4.1666667908e-02f + r2 * (-1.3888889225e-03f + r2 * (2.4801587642e-05f + r2 * -2.7557314297e-07f))));
            const int q = (int)((long long)kq & 3);
            const float c = (q == 0) ? cs : (q == 1) ? -sn : (q == 2) ? -cs : sn;
            const float s = (q == 0) ? sn : (q == 1) ? cs : (q == 2) ? -sn : -cs;
            TAB[idx] = pk2(c, s);
          } }
    }
    SEAM(0);
    if (IN(1)) REP(1) {
        pg8::Gemm g{WSP(bf16, WS_H), WSP(bf16, WS_WIN), T, INP, DM, nullptr}; pg8::StaticOrder S; S.init(T, INP, G, bx);
        epi::EpiProj E{WSP(bf16, WS_QS), WSP(bf16, WS_CQ), WSP(bf16, WS_CKV), WSP(bf16, WS_KROPE), WSP(float, WS_SSQQ), WSP(float, WS_SSQKV), WSP(unsigned, WS_TAB)};
        pg8::gemm_phase<epi::EpiProj, pg8::StaticOrder, true, false>(lds + RING_OFF, g, S, E);
    }
    SEAM(1);
    if (IN(2)) REP(2) {
#ifndef P2SEL
#define P2SEL 3
#endif
        if (P2SEL & 1) { pg8::Gemm g{WSP(bf16, WS_CQ), WSP(bf16, WS_WUQ), T, 768, 256, nullptr}; pg8::StaticOrder S; S.init(T, 768, G, bx);
          epi::EpiQup E{WSP(bf16, WS_QM), WSP(float, WS_SSQQ), WSP(unsigned, WS_TAB)};
          pg8::gemm_phase<epi::EpiQup, pg8::StaticOrder, true, false>(lds + RING_OFF, g, S, E); }
        if (P2SEL & 2) { pg8::Gemm g{WSP(bf16, WS_CKV), WSP(bf16, WS_WUKV), T, 1024, 128, nullptr};   pg8::StaticOrder S; S.init(T, 1024, G, bx);
          epi::EpiKVup E{WSP(bf16, WS_KVM), WSP(float, WS_SSQKV)};
          pg8::gemm_phase<epi::EpiKVup, pg8::StaticOrder, true, false>(lds + RING_OFF, g, S, E); }
    }
    SEAM(2);
    if (IN(3)) {
        { const att::Tensors TS{WSP(bf16, WS_QS), 512, 64, WSP(bf16, WS_KS), 512, 64, nullptr, WSP(bf16, WS_VS), 512, 64, WSP(bf16, WS_O), 0, WSP(float, WS_OSS), 0};
#ifndef XW_REPS
#define XW_REPS 1
#endif
          const int xw_at = 7 - ((bx >> 3) & 7);
          for (int u = bx; u < BATCH * NH; u += G)
              if (ATT_SEL & 1) REP(30) { int lo = 1 << 20; for (int qb = 7; qb >= 0; --qb) {
                  if (qb == xw_at && u == bx) {
                      LAS float* scr = (LAS float*)(lds + RING_OFF + 4096 + wave * 16384);
                      for (int xrep_ = 0; xrep_ < XW_REPS; ++xrep_)
                      { int lane_x = threadIdx.x & 63; asm volatile("" : "+v"(lane_x));
#define lane lane_x
                      { const XwSrc XS{(uintptr_t)FIN(16), (long long)((uintptr_t)FIN(17) - (uintptr_t)FIN(16)), (uintptr_t)FIN(18), (uintptr_t)FIN(11), (uintptr_t)WSP(bf16, WS_WGU), (uintptr_t)WSP(bf16, WS_WD)};
                        f32x4 a0[8], b0[8], c0[8], d0[8]; float ag[8], bg[8], cg[8], dg[8];
#define XI(n) ((base + (n) * NGW) < XW_NI ? (base + (n) * NGW) : XW_NI - 1)
                        for (int base = gw; base < XW_NI; base += 6 * NGW) {
                            xw_load(XS, XI(0), lane, a0, ag); xw_load(XS, XI(1), lane, b0, bg); xw_load(XS, XI(2), lane, c0, cg);
                            xw_load(XS, XI(3), lane, d0, dg); xw_store(XS, XI(0), lane, scr, a0, ag);
                            xw_load(XS, XI(4), lane, a0, ag); xw_store(XS, XI(1), lane, scr, b0, bg);
                            xw_load(XS, XI(5), lane, b0, bg); xw_store(XS, XI(2), lane, scr, c0, cg);
                            xw_store(XS, XI(3), lane, scr, d0, dg); xw_store(XS, XI(4), lane, scr, a0, ag); xw_store(XS, XI(5), lane, scr, b0, bg);
                        } }
#undef XI
#undef lane
                      }
                      lo = 1 << 20; __syncthreads();
                  }
                  att::sb_unit(lds + RING_OFF, u, qb, TS, lo); } } }
        { bf16* KVM = WSP(bf16, WS_KVM);
          const att::Tensors TM{WSP(bf16, WS_QM), 768, 96, KVM, 1024, 128, WSP(bf16, WS_KROPE), KVM + 64, 1024, 128, WSP(bf16, WS_O), 512, WSP(float, WS_OSS), 8};
          for (int u = bx; u < BATCH * NH; u += G)
              if (ATT_SEL & 2) REP(31) for (int qb = 3; qb >= 0; --qb) att::attn_unit<1>(lds + RING_OFF, u, qb, TM, qb != 3, qb != 0); }
    }
    SEAM(3);
    if (IN(5)) REP(5) {
        pg8::Gemm g{WSP(bf16, WS_O), WSP(bf16, WS_WOUT), T, DM, DM, nullptr}; pg8::StaticOrder S; S.init(T, DM, G, bx);
        epi::EpiX1 E{WSP(bf16, WS_H), FIN(2), WSP(bf16, WS_X1B), WSP(float, WS_SSQ2), WSP(float, WS_OSS), WSP(float, WS_INV1), (LAS float*)(lds + LDSCTL_OFF + 1024)};
        pg8::gemm_phase<epi::EpiX1, pg8::StaticOrder, true, false>(lds + RING_OFF, g, S, E);
    }
    SEAM(5);
    if (IN(6)) REP(6) {
        pg8::Gemm g{WSP(bf16, WS_X1B), WSP(bf16, WS_WR), T, 256, DM, nullptr}; pg8::StaticOrder S; S.init(T, 256, G, bx);
        LAS int* ebuf = (LAS int*)(lds + LDSCTL_OFF + 1024); LAS int* wcnt = (LAS int*)(lds + LDSCTL_OFF + 1024 + 2048);
        int* EIDX = WSP(int, WS_EIDX); int* RANK = WSP(int, WS_RANK); int* CNT = WSP(int, WS_CNT);
        epi::EpiRouter E{WSP(float, WS_SSQ2), WSP(float, WS_RSTD2), FIN(13), FIN(15), EIDX, WSP(float, WS_EW), ebuf};
        pg8::Unit u;
        for (int i = 0; S.next(i, u); ++i) {
            epi::OneUnit S1{u};
            pg8::gemm_phase<epi::EpiRouter, epi::OneUnit, true, false>(lds + RING_OFF, g, S1, E);
            __syncthreads();
            const int ch = u.pm; int tq = tid; asm volatile("" : "+v"(tq));
            int e0 = -1, e1 = -1;
            if (tq < 256) { e0 = ebuf[tq * 2]; e1 = ebuf[tq * 2 + 1]; }
            int rk0 = 0, rk1 = 0;
            const unsigned long long ltm = (1ull << lane) - 1ull;
            for (int e = 0; e < NEXP; ++e) {
                const unsigned long long k0 = __ballot(e0 == e), k1 = __ballot(e1 == e);
                if (e0 == e) rk0 = __popcll(k0 & ltm);
                if (e1 == e) rk1 = __popcll(k1 & ltm);
                if (lane == 0 && wave < 4) { wcnt[(wave * 2 + 0) * 32 + e] = __popcll(k0); wcnt[(wave * 2 + 1) * 32 + e] = __popcll(k1); }
            }
            __syncthreads();
            if (tq < 256) {
                int b0 = 0, b1 = 0;
                for (int sg = 0; sg < wave * 2; ++sg) { b0 += wcnt[sg * 32 + e0]; b1 += wcnt[sg * 32 + e1]; }
                b1 += wcnt[(wave * 2) * 32 + e1];
                const int tok = ch * 256 + tq; RANK[tok * 2] = b0 + rk0; RANK[tok * 2 + 1] = b1 + rk1;
            }
            if (tq < 32) { int sm = 0; for (int sg = 0; sg < 8; ++sg) sm += wcnt[sg * 32 + tq]; CNT[ch * 32 + tq] = sm; }
            __syncthreads();
        }
    }
    SEAM(6);
    if (IN(8)) REP(8) {
        int tq = tid; asm volatile("" : "+v"(tq));
        LAS int* tot = (LAS int*)(lds + RING_OFF); LAS int* pbase = tot + 32; LAS int* mybase = tot + 72;
        const int* EIDX = WSP(int, WS_EIDX); const float* EW = WSP(float, WS_EW); const int* RANK = WSP(int, WS_RANK); const int* CNT = WSP(int, WS_CNT);
        int* TILEE = WSP(int, WS_TILEE); int* SLOTTOK = WSP(int, WS_SLOTTOK); float* SLOTW = WSP(float, WS_SLOTW); float* SLOTRS = WSP(float, WS_SLOTRS); const float* RSTD2 = WSP(float, WS_RSTD2);
        for (int ch = bx; ch < T / 256; ch += G) {
            { LAS int* part = tot + 128;
              const int e = tq & 31, cg = tq >> 5; int t = 0, mb = 0;
#pragma unroll
              for (int i = 0; i < 16; ++i) { const int c = cg * 16 + i; const int v = CNT[c * 32 + e]; t += v; mb += (c < ch) ? v : 0; }
              part[(cg * 2 + 0) * 32 + e] = t; part[(cg * 2 + 1) * 32 + e] = mb;
              __syncthreads();
              if (tq < 32) { int ts = 0, ms = 0;
#pragma unroll
                  for (int g = 0; g < 16; ++g) { ts += part[(g * 2 + 0) * 32 + tq]; ms += part[(g * 2 + 1) * 32 + tq]; }
                  tot[tq] = ts; mybase[tq] = ms; } }
            __syncthreads();
            if (tq == 0) { int pb = 0; for (int e = 0; e < NEXP; ++e) { pbase[e] = pb; pb += ((tot[e] + 255) >> 8) << 8; } pbase[32] = pb; }
            __syncthreads();
            if (tq < 256) { const int tok = ch * 256 + tq; const float rs2 = RSTD2[tok];
#pragma unroll
                for (int k = 0; k < 2; ++k) { const int e = EIDX[tok * 2 + k]; const int slot = pbase[e] + mybase[e] + RANK[tok * 2 + k]; SLOTTOK[slot] = tok * 2 + k; SLOTRS[slot] = rs2; SLOTW[slot] = EW[tok * 2 + k]; } }
            if (ch < NEXP) { const int e = ch; const int endp = pbase[e] + (((tot[e] + 255) >> 8) << 8);
                for (int s = pbase[e] + tot[e] + tq; s < endp; s += NWAVES * 64) { SLOTTOK[s] = -1; SLOTW[s] = 0.f; SLOTRS[s] = 0.f; } }
            if (ch == 0) { if (tq < 32) { const int nte = (tot[tq] + 255) >> 8; for (int tl = 0; tl < nte; ++tl) TILEE[(pbase[tq] >> 8) + tl] = tq; }
                           if (tq == 0) TILEE[MAXTILES] = pbase[32] >> 8; }
            __syncthreads();
        }
    }
    SEAM(8);
    if (IN(9)) REP(9) {
        const int* TILEE = WSP(int, WS_TILEE); const int* SLOTTOK = WSP(int, WS_SLOTTOK);
        const int ntiles = TILEE[MAXTILES]; const int n6 = ntiles * 2, full = (n6 / G) * G;
        pg8::Gemm g{WSP(bf16, WS_X1B), WSP(bf16, WS_WGU), T, 512, DM, SLOTTOK}; epi::MoeOrder S{TILEE, ntiles, 2, G, bx, full};
        epi::EpiGateUp E{WSP(float, WS_SLOTRS), WSP(bf16, WS_HID)};
        pg8::gemm_phase<epi::EpiGateUp, epi::MoeOrder, true, true>(lds + RING_OFF, g, S, E);
    }
    SEAM(9);
    if (IN(10)) REP(10) {
        const int* TILEE = WSP(int, WS_TILEE);
        const int ntiles = TILEE[MAXTILES]; const int n6 = ntiles * 2, full = (n6 / G) * G, nlate = n6 - full, tile0 = full >> 1;
        unsigned* lcnt = (unsigned*)(ctl + CW_LATE);
        if (bx < nlate) {
            const int L6 = full + bx; pg8::Unit u; u.pm = L6 >> 1; u.pn = TILEE[L6 >> 1] * 2 + (L6 & 1);
            pg8::Gemm g{WSP(bf16, WS_X1B), WSP(bf16, WS_WGU), T, 512, DM, WSP(int, WS_SLOTTOK)}; epi::OneUnit S1{u};
            epi::EpiGateUp E{WSP(float, WS_SLOTRS), WSP(bf16, WS_HID)};
            pg8::gemm_phase<epi::EpiGateUp, epi::OneUnit, true, true>(lds + RING_OFF, g, S1, E);
            asm volatile("s_waitcnt vmcnt(0)" ::: "memory"); __syncthreads();
            if (tid == 0) { __builtin_amdgcn_fence(__ATOMIC_RELEASE, "agent"); asm volatile("s_waitcnt vmcnt(0)" ::: "memory");
                __hip_atomic_fetch_add(lcnt + 64 * ((L6 >> 1) - tile0), 1u, __ATOMIC_RELAXED, __HIP_MEMORY_SCOPE_AGENT); }
        }
        pg8::Gemm g{WSP(bf16, WS_HID), WSP(bf16, WS_WD), MAXTILES * 256, 1024, DEXP, nullptr};
        epi::LateOrder S{TILEE, ntiles, G, bx, nlate, tile0, lcnt, (unsigned*)(ctl + CW_LATE_TMO)};
        epi::EpiDown E{WSP(int, WS_SLOTTOK), WSP(float, WS_SLOTW), WSP(unsigned char, WS_YB)};
        pg8::gemm_phase<epi::EpiDown, epi::LateOrder, true, false>(lds + RING_OFF, g, S, E);
    }
    SEAM(10);
    if (IN(11)) REP(11) {
        const bf16* X1B = WSP(bf16, WS_X1B); const unsigned char* YB = WSP(unsigned char, WS_YB); float* outp = KA->out;
        f32x4 gn[4];
#pragma unroll
        for (int j = 0; j < 4; ++j) gn[j] = *((const GAS f32x4*)FIN(19) + lane + 64 * j);
        for (int m = gw; m < T; m += NGW) {
            const GAS u32x2v* xr = (const GAS u32x2v*)(X1B + (size_t)m * DM) + lane;
            const GAS unsigned* y0 = (const GAS unsigned*)(YB + (size_t)(2 * m) * DM) + lane; const GAS unsigned* y1 = (const GAS unsigned*)(YB + (size_t)(2 * m + 1) * DM) + lane;
            f32x4 v[4]; float s2 = 0.f;
#pragma unroll
            for (int j = 0; j < 4; ++j) { const u32x2v c = __builtin_nontemporal_load(xr + 64 * j); const int a = (int)__builtin_nontemporal_load(y0 + 64 * j), b = (int)__builtin_nontemporal_load(y1 + 64 * j);
                const f32x2v a0 = __builtin_amdgcn_cvt_pk_f32_fp8(a, false), a1 = __builtin_amdgcn_cvt_pk_f32_fp8(a, true), b0 = __builtin_amdgcn_cvt_pk_f32_fp8(b, false), b1 = __builtin_amdgcn_cvt_pk_f32_fp8(b, true);
                v[j].x = bflo(c.x) + (a0.x + b0.x) * (1.0f / YB_SCALE); v[j].y = bfhi(c.x) + (a0.y + b0.y) * (1.0f / YB_SCALE); v[j].z = bflo(c.y) + (a1.x + b1.x) * (1.0f / YB_SCALE); v[j].w = bfhi(c.y) + (a1.y + b1.y) * (1.0f / YB_SCALE);
                s2 += (v[j].x * v[j].x + v[j].y * v[j].y) + (v[j].z * v[j].z + v[j].w * v[j].w); }
            const float rstd = rsqrtf(wave_sum(s2) * (1.f / DM) + EPS);
            GAS f32x4* orow = (GAS f32x4*)(outp + (size_t)m * DM) + lane;
#pragma unroll
            for (int j = 0; j < 4; ++j) orow[64 * j] = v[j] * rstd * gn[j];
        }
    }
#undef IN
#undef SEAM
}

#ifndef MK_N_LAUNCHES
#define MK_N_LAUNCHES 1
#endif
extern "C" void kernel_launch(void* const* d_in, const int* in_sizes, int n_in, void* d_out, int out_size, void* d_ws, size_t ws_size, hipStream_t stream) {
    static int grid = 0;
    if (grid == 0) {
        if (n_in != 20 || in_sizes[0] != T * DM || out_size != T * DM || ws_size < WS_END) { fprintf(stderr, "kernel_launch: unexpected shapes (n_in %d, in0 %d, out %d, ws %zu)\n", n_in, n_in > 0 ? in_sizes[0] : -1, out_size, ws_size); grid = -1; return; }
        int dev = 0, cus = 0, per_cu = 0;
        if (hipGetDevice(&dev) != hipSuccess || hipDeviceGetAttribute(&cus, hipDeviceAttributeMultiprocessorCount, dev) != hipSuccess) { grid = -1; return; }
        if (hipFuncSetAttribute((const void*)fwd_kernel, hipFuncAttributeMaxDynamicSharedMemorySize, LDS_BYTES) != hipSuccess) { fprintf(stderr, "kernel_launch: hipFuncSetAttribute failed\n"); grid = -1; return; }
        if (hipOccupancyMaxActiveBlocksPerMultiprocessor(&per_cu, (const void*)fwd_kernel, NWAVES * 64, LDS_BYTES) != hipSuccess || per_cu < 1) { fprintf(stderr, "kernel_launch: occupancy query reports %d blocks per CU\n", per_cu); }
        (void)hipGetLastError();
        grid = cus;
    }
    if (grid < 0) return;
    if (hipMemsetAsync((char*)d_ws + WS_CTL, 0, CTL_ZERO_BYTES, stream) != hipSuccess) return;
    Args a{};
    for (int i = 0; i < 20; ++i) a.in[i] = d_in[i];
    a.out = (float*)d_out; a.ws = (unsigned char*)d_ws;
    if (MK_N_LAUNCHES == 1) { a.ph_lo = 0; a.ph_hi = NPHASE; hipLaunchKernelGGL(fwd_kernel, dim3(grid), dim3(NWAVES * 64), LDS_BYTES, stream, a); }
    else for (int p = 0; p < NPHASE; ++p) { a.ph_lo = p; a.ph_hi = p + 1; hipLaunchKernelGGL(fwd_kernel, dim3(grid), dim3(NWAVES * 64), LDS_BYTES, stream, a); }
}
```

```cpp
#include <hip/hip_runtime.h>
#include <cstdio>
#include <cstdint>
#include <cmath>
namespace pg8 {
#define PG8_LAS __attribute__((address_space(3)))
typedef unsigned short bf16_t;
typedef short bf16x8 __attribute__((ext_vector_type(8)));
typedef float f32x4 __attribute__((ext_vector_type(4)));
typedef unsigned u32x4 __attribute__((ext_vector_type(4)));
constexpr int BM = 256, BK = 64, HALF = 128, HTB = HALF * BK * 2  , STAGE_BYTES = 8 * HTB, NXCD = 8, WGM = 16;

__host__ __device__ __forceinline__ int lds_byte(int r, int c) { const int st = (r >> 4) * 2 + (c >> 5), rr = r & 15, cc = c & 31, ob = rr * 64 + cc * 2; return st * 1024 + (ob ^ (((ob >> 9) & 1) << 5)); }
__host__ __device__ __forceinline__ void stage_rc(int b, int& R, int& C) { const int st = b / 1024, sb = b % 1024, swz = sb ^ (((sb >> 9) & 1) << 5); R = (st >> 1) * 16 + swz / 64; C = (st & 1) * 32 + (swz % 64) / 2; }
__host__ __device__ __forceinline__ int perm32(int rho) { const int n = rho >> 4, i = rho & 15; return 8 * (i >> 2) + 4 * n + (i & 3); }

struct Unit { int pm, pn; };
struct Gemm { const bf16_t* A; const bf16_t* Bt; int M, N, K; const int* rowtok; };

struct StaticOrder {
    int nM, nN, nwg, G, c;
    __host__ __device__ __forceinline__ void init(int M, int N, int G_, int c_) { nM = M / BM; nN = N / BM; nwg = nM * nN; G = G_; c = c_; }
    __host__ __device__ __forceinline__ bool next(int i, Unit& u) const {
        const long L = (long)i * G + c; if (L >= nwg) return false;
        int wgid = (int)L; { const int q = nwg / NXCD, r = nwg % NXCD, xcd = wgid % NXCD, off = wgid / NXCD; wgid = (xcd < r ? xcd * (q + 1) : r * (q + 1) + (xcd - r) * q) + off; }
        const int nig = WGM * nN, gid = wgid / nig, fm = gid * WGM, gsz = (nM - fm) < WGM ? (nM - fm) : WGM;
        u.pm = fm + ((wgid % nig) % gsz); u.pn = (wgid % nig) / gsz; return true;
    }
    __device__ __forceinline__ void a_ready(const Unit&) const {}
    __device__ __forceinline__ void done(const Unit&) const {}
};

typedef float f32x2_t __attribute__((ext_vector_type(2))); typedef __bf16 bf16x2_t __attribute__((ext_vector_type(2)));
__device__ __forceinline__ unsigned cvt_pk_bf16(float lo, float hi) { f32x2_t v = {lo, hi}; bf16x2_t b = __builtin_convertvector(v, bf16x2_t); return __builtin_bit_cast(unsigned, b); }

template <class Epi, class Sched, bool ALIGN_EPI, bool GATHER>
__device__ __forceinline__ void gemm_phase(PG8_LAS unsigned char* lds, const Gemm g, const Sched& S, const Epi& E) {
    const int tid = threadIdx.x, wid = __builtin_amdgcn_readfirstlane(tid >> 6), lane = tid & 63, wr = wid >> 2, wc = wid & 3, fr = lane & 15, fq = lane >> 4;
    const int K = g.K, nt = K / BK;
    unsigned voffA[2], voffB[2]; int RA[2], CA[2];
#pragma unroll
    for (int i = 0; i < 2; ++i) { int R, C; stage_rc(tid * 16 + i * 8192, R, C); const int Rb = Epi::PERM ? ((R & ~31) + perm32(R & 31)) : R;
        voffA[i] = (unsigned)(R * K + C) * 2u; voffB[i] = (unsigned)(Rb * K + C) * 2u; RA[i] = R; CA[i] = C; }
    const size_t kstep = (size_t)(BK * 2);
    const size_t hstep = (size_t)HALF * K * 2;
    const size_t tstep = 2 * hstep;
    const unsigned ldsw = (unsigned)wid * 1024u;
    const int aoff = lds_byte(wr * 64 + fr, fq * 8), boff = lds_byte(wc * 32 + fr, fq * 8);
#define PG8_SA(b, h) (((b) * 2 + (h)) * HTB)
#define PG8_SB(b, h) ((4 + (b) * 2 + (h)) * HTB)
#define PG8_STAGE(bufoff, gbase, voff) do { _Pragma("unroll") for (int _i = 0; _i < 2; ++_i) \
        __builtin_amdgcn_global_load_lds((const unsigned*)((const char*)(gbase) + (voff)[_i]), (PG8_LAS unsigned*)(lds + (bufoff) + ldsw + _i * 8192), 16, 0, 0); } while (0)
#define PG8_STAGE_A(b, h, p, OFF) do { if constexpr (GATHER) { PG8_STAGE(PG8_SA(b, h), (p), OFF[h]); } else { PG8_STAGE(PG8_SA(b, h), (p) + (h) * hstep, voffA); } } while (0)
#define PG8_LDA(dst, b, h) do { _Pragma("unroll") for (int m = 0; m < 4; ++m) _Pragma("unroll") for (int k = 0; k < 2; ++k) dst[m][k] = *(const PG8_LAS bf16x8*)(lds + PG8_SA(b, h) + aoff + m * 2048 + k * 1024); } while (0)
#define PG8_LDB(dst, b, h) do { _Pragma("unroll") for (int n = 0; n < 2; ++n) _Pragma("unroll") for (int k = 0; k < 2; ++k) dst[n][k] = *(const PG8_LAS bf16x8*)(lds + PG8_SB(b, h) + boff + n * 2048 + k * 1024); } while (0)
#define PG8_MMA(ai, bj, At, Bt) do { __builtin_amdgcn_s_setprio(1); _Pragma("unroll") for (int m = 0; m < 4; ++m) _Pragma("unroll") for (int n = 0; n < 2; ++n) _Pragma("unroll") for (int k = 0; k < 2; ++k) \
        acc[ai][bj][m][n] = __builtin_amdgcn_mfma_f32_16x16x32_bf16(Bt[n][k], At[m][k], acc[ai][bj][m][n], 0, 0, 0); __builtin_amdgcn_s_setprio(0); } while (0)
#define PG8_WAIT_V(n) asm volatile("s_waitcnt vmcnt(" #n ")" ::: "memory")
#define PG8_WAIT_L(n) asm volatile("s_waitcnt lgkmcnt(" #n ")" ::: "memory")
#define PG8_BAR __builtin_amdgcn_s_barrier()
#define PG8_SCHED __builtin_amdgcn_sched_barrier(0)
#define PG8_GOFF(dst, pm_) do { _Pragma("unroll") for (int _h = 0; _h < 2; ++_h) _Pragma("unroll") for (int _i = 0; _i < 2; ++_i) { \
        int _t = g.rowtok[(pm_) * BM + _h * HALF + RA[_i]]; _t = _t < 0 ? 0 : (_t >> 1); dst[_h][_i] = (unsigned)(_t * K + CA[_i]) * 2u; } } while (0)
    Unit cur, nxt; int ui = 0;
    if (!S.next(0, cur)) return;
    f32x4 acc[2][2][4][2];
    if constexpr (Epi::HAS_INIT) { E.init(acc, cur, wr, wc, fr, fq); } else {
#pragma unroll
    for (int a = 0; a < 2; ++a)
#pragma unroll
        for (int b = 0; b < 2; ++b)
#pragma unroll
            for (int m = 0; m < 4; ++m)
#pragma unroll
                for (int n = 0; n < 2; ++n) acc[a][b][m][n] = (f32x4){0.f, 0.f, 0.f, 0.f};
    }
    bf16x8 At[4][2], B0[2][2], B1[2][2];
    unsigned oC[2][2] = {{0u, 0u}, {0u, 0u}}, oN[2][2] = {{0u, 0u}, {0u, 0u}}, o2[2][2] = {{0u, 0u}, {0u, 0u}};
    if constexpr (GATHER) { PG8_GOFF(oC, cur.pm); }
    const char* cA = GATHER ? (const char*)g.A : (const char*)g.A + (size_t)cur.pm * tstep; const char* cB = (const char*)g.Bt + (size_t)cur.pn * tstep;
    S.a_ready(cur);
    PG8_STAGE(PG8_SB(0, 0), cB, voffB); PG8_STAGE(PG8_SB(0, 1), cB + hstep, voffB); PG8_STAGE_A(0, 0, cA, oC); PG8_STAGE_A(0, 1, cA, oC);
    if (wr == 1) PG8_BAR;
    PG8_WAIT_V(2); PG8_BAR;
    PG8_STAGE(PG8_SB(1, 0), cB + kstep, voffB); PG8_STAGE_A(1, 0, cA + kstep, oC); PG8_STAGE(PG8_SB(1, 1), cB + hstep + kstep, voffB);
    PG8_WAIT_V(6); PG8_BAR;
    for (;;) {
        const bool has_next = S.next(ui + 1, nxt);
        if constexpr (GATHER) { if (has_next) { PG8_GOFF(oN, nxt.pm); } }
        const char* nA = GATHER ? cA : (has_next ? (const char*)g.A + (size_t)nxt.pm * tstep : cA); const char* nB = has_next ? (const char*)g.Bt + (size_t)nxt.pn * tstep : cB;
#pragma clang loop unroll(disable)
        for (int t = 0; t < nt; t += 2) {
            const bool last = (t == nt - 2);
            const char* a1 = cA + (size_t)(t + 1) * kstep;
            const char* a2 = last ? nA : cA + (size_t)(t + 2) * kstep; const char* b2 = last ? nB : cB + (size_t)(t + 2) * kstep;
            const char* a3 = a2 + kstep; const char* b3 = b2 + kstep;
            if constexpr (GATHER) { const bool sel = last && has_next;
#pragma unroll
                for (int h = 0; h < 2; ++h)
#pragma unroll
                    for (int i = 0; i < 2; ++i) o2[h][i] = sel ? oN[h][i] : oC[h][i]; }
            if (last && has_next) S.a_ready(nxt);
            if constexpr (Epi::HAS_MIDK) { if (t == Epi::MIDT) E.midk(acc, cur, wr, wc, fr, fq); }
            PG8_LDB(B0, 0, 0); PG8_LDB(B1, 0, 1); PG8_SCHED; PG8_LDA(At, 0, 0); PG8_STAGE_A(1, 1, a1, oC);
            PG8_WAIT_V(8); PG8_WAIT_L(0); PG8_BAR; PG8_MMA(0, 0, At, B0); PG8_MMA(0, 1, At, B1); PG8_BAR; PG8_SCHED;
            PG8_LDA(At, 0, 1); PG8_STAGE(PG8_SB(0, 0), b2, voffB); PG8_STAGE(PG8_SB(0, 1), b2 + hstep, voffB); PG8_STAGE_A(0, 0, a2, o2);
            PG8_WAIT_V(8); PG8_WAIT_L(0); PG8_BAR; PG8_MMA(1, 0, At, B0); PG8_MMA(1, 1, At, B1); PG8_BAR; PG8_SCHED;
            PG8_LDB(B0, 1, 0); PG8_LDB(B1, 1, 1); PG8_SCHED; PG8_LDA(At, 1, 0); PG8_STAGE_A(0, 1, a2, o2);
            PG8_WAIT_V(8); PG8_WAIT_L(0); PG8_BAR; PG8_MMA(0, 0, At, B0); PG8_MMA(0, 1, At, B1); PG8_BAR; PG8_SCHED;
            PG8_LDA(At, 1, 1); PG8_STAGE(PG8_SB(1, 0), b3, voffB); PG8_STAGE(PG8_SB(1, 1), b3 + hstep, voffB); PG8_STAGE_A(1, 0, a3, o2);
            PG8_WAIT_V(8); PG8_WAIT_L(0); PG8_BAR; PG8_MMA(1, 0, At, B0); PG8_MMA(1, 1, At, B1); PG8_BAR; PG8_SCHED;
        }
        if constexpr (ALIGN_EPI) { if (wr == 0) PG8_BAR; }
        E(acc, cur, wr, wc, fr, fq); S.done(cur);
        if (!has_next) break;
        if constexpr (Epi::HAS_INIT) { E.init(acc, nxt, wr, wc, fr, fq); } else {
#pragma unroll
        for (int a = 0; a < 2; ++a)
#pragma unroll
            for (int b = 0; b < 2; ++b)
#pragma unroll
                for (int m = 0; m < 4; ++m)
#pragma unroll
                    for (int n = 0; n < 2; ++n) acc[a][b][m][n] = (f32x4){0.f, 0.f, 0.f, 0.f};
        }
        cur = nxt; cA = nA; cB = nB; ++ui;
        if constexpr (GATHER) {
#pragma unroll
            for (int h = 0; h < 2; ++h)
#pragma unroll
                for (int i = 0; i < 2; ++i) oC[h][i] = oN[h][i]; }
        if constexpr (ALIGN_EPI) { if (wr == 1) PG8_BAR; }
    }
    PG8_WAIT_V(0);
    if constexpr (!ALIGN_EPI) { if (wr == 0) PG8_BAR; }
    PG8_BAR;
#undef PG8_SA
#undef PG8_SB
#undef PG8_STAGE
#undef PG8_STAGE_A
#undef PG8_LDA
#undef PG8_LDB
#undef PG8_MMA
#undef PG8_WAIT_V
#undef PG8_WAIT_L
#undef PG8_BAR
#undef PG8_SCHED
#undef PG8_GOFF
}
}

constexpr int NWAVES = 8;
constexpr int BATCH = 32, SEQ = 2048, DM = 1024, T = BATCH * SEQ;
constexpr int NH = 8, HD = 64, SBW = 512, MLAW = 512, QLORA = 256, KVLORA = 128, ROPE = 32, NOPE = 64, QKD = 96;
constexpr int INC = 1952, INP = 2048;
constexpr int NEXP = 32, NGRP = 4, EPG = 8, DEXP = 256;
constexpr int MAXTILES = 544;
constexpr float EPS = 1e-6f;
constexpr float LOG2E = 1.4426950408889634f;
constexpr float SB_C2 = 0.125f * LOG2E;
constexpr float YB_SCALE = 8.0f;
constexpr float MLA_C2 = 0.10206207261596575f * LOG2E;

constexpr size_t MiB = 1u << 20;
constexpr size_t WS_CTL = 0, CTL_ZERO_BYTES = 1 * MiB;
constexpr size_t WS_WIN = 2 * MiB;
constexpr size_t WS_WUQ = 6 * MiB;
constexpr size_t WS_WUKV = 7 * MiB;
constexpr size_t WS_WOUT = 8 * MiB;
constexpr size_t WS_WR = 10 * MiB;
constexpr size_t WS_WGU = 11 * MiB;
constexpr size_t WS_WD = 43 * MiB;
constexpr size_t WS_TAB = 60 * MiB;
constexpr size_t WS_SSQQ = 68 * MiB;
constexpr size_t WS_SSQKV = 69 * MiB;
constexpr size_t WS_OSS = 70 * MiB;
constexpr size_t WS_SSQ2 = 74 * MiB;
constexpr size_t WS_RSTD2 = 78 * MiB;
constexpr size_t WS_INV1 = 78 * MiB + 512 * 1024;
constexpr size_t WS_RS3 = 105 * MiB;
constexpr size_t WS_EIDX = 79 * MiB;
constexpr size_t WS_EW = 80 * MiB;
constexpr size_t WS_RANK = 81 * MiB;
constexpr size_t WS_CNT = 82 * MiB;
constexpr size_t WS_TILEE = 82 * MiB + 65536;
constexpr size_t WS_SLOTTOK = 83 * MiB;
constexpr size_t WS_SLOTW = 84 * MiB;
constexpr size_t WS_SLOTRS = 84 * MiB + 640 * 1024;
constexpr size_t WS_LOGITS = 85 * MiB;
constexpr size_t WS_KROPE = 101 * MiB;
constexpr size_t WS_H = 106 * MiB;
constexpr size_t WS_QM = 874 * MiB;
constexpr size_t WS_X1B = 234 * MiB;
constexpr size_t WS_QS = 234 * MiB, WS_KS = 298 * MiB, WS_VS = 362 * MiB;
constexpr size_t WS_CQ = 426 * MiB;
constexpr size_t WS_CKV = 458 * MiB;
constexpr size_t WS_X1 = 234 * MiB;
constexpr size_t WS_KVM = 490 * MiB;
constexpr size_t WS_HID = 490 * MiB;
constexpr size_t WS_O = 618 * MiB;
constexpr size_t WS_YB = 618 * MiB;
constexpr size_t WS_END = 970 * MiB;
constexpr int CW_BAR = 4096;
constexpr int CW_LATE = 16384, CW_LATE_TMO = 16384 + 64 * 64;

constexpr int RING_OFF = 0, RING_BYTES = 131072;
constexpr int LDSCTL_OFF = RING_BYTES, MISC_OFF = LDSCTL_OFF + 320;
constexpr int LDS_BYTES = 147456;

#define GAS __attribute__((address_space(1)))
#define LAS __attribute__((address_space(3)))
typedef unsigned short bf16;
typedef unsigned v4u __attribute__((ext_vector_type(4)));
typedef float f32x4 __attribute__((ext_vector_type(4)));
typedef short bf16x8 __attribute__((ext_vector_type(8)));
typedef GAS unsigned gu32;
typedef GAS unsigned long long gu64;
#define RLX_AGENT __ATOMIC_RELAXED, __HIP_MEMORY_SCOPE_AGENT
#define LDS_WAIT() asm volatile("s_waitcnt lgkmcnt(0)" ::: "memory")
#define VM_WAIT() asm volatile("s_waitcnt vmcnt(0)" ::: "memory")
__device__ __forceinline__ unsigned long long rt() { return __builtin_amdgcn_s_memrealtime(); }
__device__ __forceinline__ unsigned f2bf(float f) { unsigned u = __builtin_bit_cast(unsigned, f); return (u + 0x7fffu + ((u >> 16) & 1u)) >> 16; }
__device__ __forceinline__ unsigned pk2(float lo, float hi) { return f2bf(lo) | (f2bf(hi) << 16); }

#define XB_TMO      128
#define XB_XCNT(j)  (256  + 64 * (j))
#define XB_XSUB(j)  (1280 + 64 * (j))
#define XB_XGEN(j)  (2304 + 64 * (j))
#define XB_TOP      3328
#define XB_TOPGEN   3392
#define XCD_BAR_WORDS 3456
#define XB_SPIN_CAP (1u << 18)

__device__ __forceinline__ unsigned xb_ld(unsigned* p)              { return __hip_atomic_load(p, __ATOMIC_RELAXED, __HIP_MEMORY_SCOPE_AGENT); }
__device__ __forceinline__ unsigned xb_add(unsigned* p, unsigned v) { return __hip_atomic_fetch_add(p, v, __ATOMIC_RELAXED, __HIP_MEMORY_SCOPE_AGENT); }
__device__ __forceinline__ unsigned xb_xcc_id() { return (unsigned)__builtin_amdgcn_s_getreg((3 << 11) | 20) & 0xFu; }
#define XB_SPIN(cond, bar) do { unsigned _sp = 0; while (cond) { __builtin_amdgcn_s_sleep(1); \
    if ((++_sp & 255u) == 0u) { if (xb_ld(&(bar)[XB_TMO])) break; if (_sp > XB_SPIN_CAP) { atomicAdd(&(bar)[XB_TMO], 1u); break; } } } } while (0)

struct XcdBarrier {
    unsigned* bar; unsigned x;
    volatile LAS unsigned* st;
};

__device__ __forceinline__ XcdBarrier xcd_barrier_post(unsigned* bar, volatile LAS unsigned* st) {
    XcdBarrier b; b.bar = bar; b.x = xb_xcc_id(); b.st = st;
    if (threadIdx.x == 0) (void)xb_add(&bar[XB_XCNT(b.x)], 1u);
    return b;
}
__device__ __forceinline__ void xcd_barrier_complete(unsigned* bar, unsigned x, unsigned& nloc, unsigned& nx) {
    const unsigned G = gridDim.x * gridDim.y * gridDim.z;
    unsigned sum, cnt, mine, sp = 0u;
    for (;;) {
        sum = 0u; cnt = 0u; mine = 0u;
#pragma unroll
        for (unsigned j = 0; j < 16; ++j) { const unsigned c = xb_ld(&bar[XB_XCNT(j)]); sum += c; cnt += (c > 0u) ? 1u : 0u; mine = (j == x) ? c : mine; }
        if (sum == G) break;
        __builtin_amdgcn_s_sleep(1);
        if ((++sp & 255u) == 0u) { if (xb_ld(&bar[XB_TMO])) break; if (sp > XB_SPIN_CAP) { atomicAdd(&bar[XB_TMO], 1u); break; } }
    }
    nloc = mine > 0u ? mine : 1u; nx = cnt > 0u ? cnt : 1u;
}

__device__ __forceinline__ void xcd_barrier(const XcdBarrier& b) {
    asm volatile("s_waitcnt vmcnt(0)" ::: "memory");
    __syncthreads();
    if (threadIdx.x == 0) {
        unsigned* bar = b.bar;
        __builtin_amdgcn_s_waitcnt(0);
        unsigned nloc = b.st[0], nx = b.st[1];
        if (nloc == 0u) { xcd_barrier_complete(bar, b.x, nloc, nx); b.st[0] = nloc; b.st[1] = nx; }
        const unsigned old = xb_add(&bar[XB_XSUB(b.x)], 1u);
        const unsigned gen = old / nloc;
        if (old + 1u == (gen + 1u) * nloc) {
            __builtin_amdgcn_fence(__ATOMIC_RELEASE, "agent");
            asm volatile("s_waitcnt vmcnt(0)" ::: "memory");
            const unsigned og = xb_add(&bar[XB_TOP], 1u);
            const unsigned tg = og / nx;
            if (og + 1u == (tg + 1u) * nx) xb_add(&bar[XB_TOPGEN], 1u);
            else XB_SPIN(xb_ld(&bar[XB_TOPGEN]) == tg, bar);
            __builtin_amdgcn_fence(__ATOMIC_ACQUIRE, "agent");
            xb_add(&bar[XB_XGEN(b.x)], 1u);
            asm volatile("s_waitcnt vmcnt(0)" ::: "memory");
        } else {
            XB_SPIN(xb_ld(&bar[XB_XGEN(b.x)]) == gen, bar);
            __builtin_amdgcn_fence(__ATOMIC_ACQUIRE, "agent");
            asm volatile("s_waitcnt vmcnt(0)" ::: "memory");
        }
    }
    __syncthreads();
}

typedef float f32x2v __attribute__((ext_vector_type(2)));
typedef unsigned u32x2v __attribute__((ext_vector_type(2)));
namespace epi {
using pg8::f32x4; using pg8::u32x4; using pg8::Unit; using pg8::bf16_t; using pg8::cvt_pk_bf16;
typedef float f32x2 __attribute__((ext_vector_type(2)));
typedef unsigned u32x2 __attribute__((ext_vector_type(2)));
__device__ __forceinline__ u32x4 pack8(const f32x4 a, const f32x4 b) { u32x4 w; w.x = cvt_pk_bf16(a[0], a[1]); w.y = cvt_pk_bf16(a[2], a[3]); w.z = cvt_pk_bf16(b[0], b[1]); w.w = cvt_pk_bf16(b[2], b[3]); return w; }
__device__ __forceinline__ float sq8(const f32x4 a, const f32x4 b) { return (a[0] * a[0] + a[1] * a[1]) + (a[2] * a[2] + a[3] * a[3]) + (b[0] * b[0] + b[1] * b[1]) + (b[2] * b[2] + b[3] * b[3]); }
__device__ __forceinline__ void rope8(f32x4& a, f32x4& b, const u32x4 tb) {
    const float c0 = __builtin_bit_cast(float, tb[0] << 16), s0 = __builtin_bit_cast(float, tb[0] & 0xffff0000u), c1 = __builtin_bit_cast(float, tb[1] << 16), s1 = __builtin_bit_cast(float, tb[1] & 0xffff0000u);
    const float c2 = __builtin_bit_cast(float, tb[2] << 16), s2 = __builtin_bit_cast(float, tb[2] & 0xffff0000u), c3 = __builtin_bit_cast(float, tb[3] << 16), s3 = __builtin_bit_cast(float, tb[3] & 0xffff0000u);
    f32x4 ra, rb;
    ra[0] = a[0] * c0 - a[1] * s0; ra[1] = a[1] * c0 + a[0] * s0;
    ra[2] = a[2] * c1 - a[3] * s1; ra[3] = a[3] * c1 + a[2] * s1;
    rb[0] = b[0] * c2 - b[1] * s2; rb[1] = b[1] * c2 + b[0] * s2;
    rb[2] = b[2] * c3 - b[3] * s3; rb[3] = b[3] * c3 + b[2] * s3;
    a = ra; b = rb;
}

struct EpiProj {
    static constexpr bool PERM = true, HAS_INIT = false, HAS_MIDK = false;
    bf16_t *QKV, *CQ, *CKV, *KROPE; float *SSQQ, *SSQKV; const unsigned* TAB;
    __device__ __forceinline__ void operator()(const f32x4 (&acc)[2][2][4][2], const Unit& u, int wr, int wc, int fr, int fq) const {
        const int pn = u.pn; int rowv = u.pm * 256 + wr * 64 + fr;
        if (pn < 6) {
            bf16_t* dst = QKV + (size_t)(pn >> 1) * ((size_t)T * 512) + (pn & 1) * 256 + wc * 32 + 8 * fq; const float sc = (pn < 2) ? SB_C2 : 1.0f;
#pragma unroll
            for (int ai = 0; ai < 2; ++ai)
#pragma unroll
                for (int m = 0; m < 4; ++m) { asm volatile("" : "+v"(rowv)); const int row = rowv; rowv += (m == 3) ? 80 : 16;
#pragma unroll
                    for (int bj = 0; bj < 2; ++bj) *(u32x4*)(dst + (size_t)row * 512 + bj * 128) = pack8(acc[ai][bj][m][0] * sc, acc[ai][bj][m][1] * sc); }
        } else if (pn == 6) {
#pragma unroll
            for (int ai = 0; ai < 2; ++ai)
#pragma unroll
                for (int m = 0; m < 4; ++m) { asm volatile("" : "+v"(rowv)); const int row = rowv; rowv += (m == 3) ? 80 : 16; float s = 0.f;
#pragma unroll
                    for (int bj = 0; bj < 2; ++bj) { const int c = bj * 128 + wc * 32 + 8 * fq;
                        *(u32x4*)(CQ + (size_t)row * 256 + c) = pack8(acc[ai][bj][m][0], acc[ai][bj][m][1]); s += sq8(acc[ai][bj][m][0], acc[ai][bj][m][1]); }
                    s += __shfl_xor(s, 16); s += __shfl_xor(s, 32);
                    if (fq == 0) SSQQ[(size_t)row * 4 + wc] = s; }
        } else {
#pragma unroll
            for (int ai = 0; ai < 2; ++ai)
#pragma unroll
                for (int m = 0; m < 4; ++m) { asm volatile("" : "+v"(rowv)); const int row = rowv; rowv += (m == 3) ? 80 : 16;
                    { const int c = wc * 32 + 8 * fq;
                      *(u32x4*)(CKV + (size_t)row * 128 + c) = pack8(acc[ai][0][m][0], acc[ai][0][m][1]);
                      float s = sq8(acc[ai][0][m][0], acc[ai][0][m][1]); s += __shfl_xor(s, 16); s += __shfl_xor(s, 32);
                      if (fq == 0) SSQKV[(size_t)row * 4 + wc] = s; }
                    if (wc == 0) {
                        f32x4 a = acc[ai][1][m][0], b = acc[ai][1][m][1];
                        rope8(a, b, *(const u32x4*)(TAB + (size_t)row * 16 + 4 * fq));
                        *(u32x4*)(KROPE + (size_t)row * 32 + 8 * fq) = pack8(a, b);
                    }
                    if (m & 1) asm volatile("" ::: "memory"); }
        }
    }
};

struct EpiQup {
    static constexpr bool PERM = true, HAS_INIT = false, HAS_MIDK = false;
    bf16_t* QM; const float* SSQQ; const unsigned* TAB;
    __device__ __forceinline__ void operator()(const f32x4 (&acc)[2][2][4][2], const Unit& u, int wr, int wc, int fr, int fq) const {
        const int row0 = u.pm * 256 + wr * 64 + fr;
        float rs[8];
#pragma unroll
        for (int i = 0; i < 8; ++i) { const f32x4 ss = *(const f32x4*)(SSQQ + (size_t)(row0 + (i >> 2) * 128 + (i & 3) * 16) * 4); rs[i] = rsqrtf(((ss[0] + ss[1]) + (ss[2] + ss[3])) * (1.0f / QLORA) + EPS) * MLA_C2; }
#pragma unroll
        for (int bj = 0; bj < 2; ++bj) {
            const int cc = u.pn * 256 + bj * 128 + wc * 32 + 8 * fq, jo = cc % QKD - NOPE;
            u32x4 tb[8];
            if (jo >= 0) { int rl = row0; asm volatile("" : "+v"(rl));
#pragma unroll
                for (int i = 0; i < 8; ++i) { tb[i] = *(const u32x4*)(TAB + (size_t)rl * 16 + (jo >> 1)); rl += ((i & 3) == 3) ? 80 : 16; }
            }
            int rowv = row0;
#pragma unroll
            for (int i = 0; i < 8; ++i) { const int ai = i >> 2, m = i & 3; asm volatile("" : "+v"(rowv)); const int row = rowv; rowv += (m == 3) ? 80 : 16;
                f32x4 a = acc[ai][bj][m][0] * rs[i], b = acc[ai][bj][m][1] * rs[i];
                if (jo >= 0) rope8(a, b, tb[i]);
                *(u32x4*)(QM + (size_t)row * 768 + cc) = pack8(a, b); }
            asm volatile("" ::: "memory");
        }
    }
};
struct EpiKVup {
    static constexpr bool PERM = true, HAS_INIT = false, HAS_MIDK = false;
    bf16_t* KVM; const float* SSQKV;
    __device__ __forceinline__ void operator()(const f32x4 (&acc)[2][2][4][2], const Unit& u, int wr, int wc, int fr, int fq) const {
        const int row0 = u.pm * 256 + wr * 64 + fr;
        float rs[8];
#pragma unroll
        for (int i = 0; i < 8; ++i) { const f32x4 ss = *(const f32x4*)(SSQKV + (size_t)(row0 + (i >> 2) * 128 + (i & 3) * 16) * 4); rs[i] = rsqrtf(((ss[0] + ss[1]) + (ss[2] + ss[3])) * (1.0f / KVLORA) + EPS); }
        int rowv = row0;
#pragma unroll
        for (int ai = 0; ai < 2; ++ai)
#pragma unroll
            for (int m = 0; m < 4; ++m) {
                asm volatile("" : "+v"(rowv)); const int row = rowv; rowv += (m == 3) ? 80 : 16;
#pragma unroll
                for (int bj = 0; bj < 2; ++bj) { const int c = u.pn * 256 + bj * 128 + wc * 32 + 8 * fq;
                    *(u32x4*)(KVM + (size_t)row * 1024 + c) = pack8(acc[ai][bj][m][0] * rs[ai * 4 + m], acc[ai][bj][m][1] * rs[ai * 4 + m]); }
            }
    }
};
struct EpiX1 {
    static constexpr bool PERM = true, HAS_INIT = true, HAS_MIDK = true; static constexpr int MIDT = 8;
    const bf16_t* H; const float* G1; bf16_t* X1B; float* SSQ2; const float* OSS; const float* INV1; __attribute__((address_space(3))) float* rsl;
    __device__ __forceinline__ void init(f32x4 (&acc)[2][2][4][2], const Unit& u, int wr, int wc, int fr, int fq) const {
        const int row0 = u.pm * 256 + wr * 64 + fr; const int c0 = u.pn * 256 + wc * 32 + 8 * fq;
        const bf16_t* hp = H + (size_t)row0 * 1024 + c0;
        f32x4 ig[2][2];
#pragma unroll
        for (int bj = 0; bj < 2; ++bj)
#pragma unroll
            for (int n = 0; n < 2; ++n) { const f32x4 gv = *(const f32x4*)(G1 + c0 + bj * 128 + 4 * n);
                ig[bj][n] = (f32x4){__builtin_amdgcn_rcpf(gv[0]), __builtin_amdgcn_rcpf(gv[1]), __builtin_amdgcn_rcpf(gv[2]), __builtin_amdgcn_rcpf(gv[3])}; }
#pragma unroll
        for (int ai = 0; ai < 2; ++ai)
#pragma unroll
            for (int m = 0; m < 4; ++m) {
                const int row = row0 + ai * 128 + m * 16; const f32x4* sp = (const f32x4*)(OSS + (size_t)row * 16);
                const f32x4 s0 = sp[0], s1 = sp[1], s2 = sp[2], s3 = sp[3];
                const float vs = (((s0[0] + s0[1]) + (s0[2] + s0[3])) + ((s1[0] + s1[1]) + (s1[2] + s1[3]))) * (1.f / 512.f) + 1e-6f, vm = (((s2[0] + s2[1]) + (s2[2] + s2[3])) + ((s3[0] + s3[1]) + (s3[2] + s3[3]))) * (1.f / 512.f) + 1e-6f;
                const float is = sqrtf(vs) * INV1[row];
                { __attribute__((address_space(3))) float* rp = rsl + (((wr * 4 + wc) * 8 + ai * 4 + m) * 16 + fr) * 2; rp[0] = rsqrtf(vs) * sqrtf(vm); rp[1] = rsqrtf(vm); }
#pragma unroll
                for (int bj = 0; bj < 2; ++bj) { const u32x4 hv = *(const u32x4*)(hp + (size_t)(ai * 128 + m * 16) * 1024 + bj * 128);
                    const f32x4 lo = {__builtin_bit_cast(float, hv[0] << 16), __builtin_bit_cast(float, hv[0] & 0xffff0000u), __builtin_bit_cast(float, hv[1] << 16), __builtin_bit_cast(float, hv[1] & 0xffff0000u)};
                    const f32x4 hi = {__builtin_bit_cast(float, hv[2] << 16), __builtin_bit_cast(float, hv[2] & 0xffff0000u), __builtin_bit_cast(float, hv[3] << 16), __builtin_bit_cast(float, hv[3] & 0xffff0000u)};
                    acc[ai][bj][m][0] = lo * ig[bj][0] * is; acc[ai][bj][m][1] = hi * ig[bj][1] * is; } }
    }
    __device__ __forceinline__ void midk(f32x4 (&acc)[2][2][4][2], const Unit& u, int wr, int wc, int fr, int fq) const {
        const int row0 = u.pm * 256 + wr * 64 + fr;
#pragma unroll
        for (int ai = 0; ai < 2; ++ai)
#pragma unroll
            for (int m = 0; m < 4; ++m) { const float rt = rsl[(((wr * 4 + wc) * 8 + ai * 4 + m) * 16 + fr) * 2];
#pragma unroll
                for (int bj = 0; bj < 2; ++bj) { acc[ai][bj][m][0] *= rt; acc[ai][bj][m][1] *= rt; } }
    }
    __device__ __forceinline__ void operator()(const f32x4 (&acc)[2][2][4][2], const Unit& u, int wr, int wc, int fr, int fq) const {
        const int row0 = u.pm * 256 + wr * 64 + fr;
        float rm[8];
#pragma unroll
        for (int i = 0; i < 8; ++i) rm[i] = rsl[(((wr * 4 + wc) * 8 + i) * 16 + fr) * 2 + 1];
        int rowv = row0;
#pragma unroll
        for (int ai = 0; ai < 2; ++ai)
#pragma unroll
            for (int m = 0; m < 4; ++m) {
                asm volatile("" : "+v"(rowv)); const int row = rowv; rowv += (m == 3) ? 80 : 16; float s = 0.f;
#pragma unroll
                for (int bj = 0; bj < 2; ++bj) { const size_t off = (size_t)row * 1024 + u.pn * 256 + bj * 128 + wc * 32 + 8 * fq;
                    const f32x4 a = acc[ai][bj][m][0] * rm[ai * 4 + m], b = acc[ai][bj][m][1] * rm[ai * 4 + m];
                    *(u32x4*)(X1B + off) = pack8(a, b); s += sq8(a, b); }
                s += __shfl_xor(s, 16); s += __shfl_xor(s, 32);
                if (fq == 0) SSQ2[(size_t)row * 16 + u.pn * 4 + wc] = s;
            }
    }
};
struct EpiRouter {
    static constexpr bool PERM = true, HAS_INIT = false, HAS_MIDK = false;
    const float* SSQ2; float* RSTD2; const float* BG; const float* BE; int* EIDX; float* EW; __attribute__((address_space(3))) int* ebuf;
    __device__ __forceinline__ void operator()(const f32x4 (&acc)[2][2][4][2], const Unit& u, int wr, int wc, int fr, int fq) const {
        if (wc != 0) return;
        const f32x4 bg = *(const f32x4*)BG, be0 = *(const f32x4*)(BE + 8 * fq), be1 = *(const f32x4*)(BE + 8 * fq + 4);
        int rowv = u.pm * 256 + wr * 64 + fr; int rlv = wr * 64 + fr;
#pragma unroll
        for (int ai = 0; ai < 2; ++ai)
#pragma unroll
            for (int m = 0; m < 4; ++m) {
                asm volatile("" : "+v"(rowv)); const int row = rowv; rowv += (m == 3) ? 80 : 16; const int rloc = rlv; rlv += (m == 3) ? 80 : 16;
                const f32x4 s0 = *(const f32x4*)(SSQ2 + (size_t)row * 16), s1 = *(const f32x4*)(SSQ2 + (size_t)row * 16 + 4), s2 = *(const f32x4*)(SSQ2 + (size_t)row * 16 + 8), s3 = *(const f32x4*)(SSQ2 + (size_t)row * 16 + 12);
                const float tot = (((s0[0] + s0[1]) + (s0[2] + s0[3])) + ((s1[0] + s1[1]) + (s1[2] + s1[3]))) + (((s2[0] + s2[1]) + (s2[2] + s2[3])) + ((s3[0] + s3[1]) + (s3[2] + s3[3])));
                const float rs = rsqrtf(tot * (1.0f / DM) + EPS);
                if (fq == 0) RSTD2[row] = rs;
                const f32x4 lg = acc[ai][0][m][0] * rs + bg;
                int gi = 0; float gm = lg[0];
                if (lg[1] > gm) { gm = lg[1]; gi = 1; } if (lg[2] > gm) { gm = lg[2]; gi = 2; } if (lg[3] > gm) { gm = lg[3]; gi = 3; }
                float gval = 1.0f / ((expf(lg[0] - gm) + expf(lg[1] - gm)) + (expf(lg[2] - gm) + expf(lg[3] - gm)));
                gi = __shfl(gi, fr); gval = __shfl(gval, fr);
                const f32x4 ea = acc[ai][1][m][0] * rs + be0, eb = acc[ai][1][m][1] * rs + be1;
                int i1 = 0; float m1 = ea[0];
                if (ea[1] > m1) { m1 = ea[1]; i1 = 1; } if (ea[2] > m1) { m1 = ea[2]; i1 = 2; } if (ea[3] > m1) { m1 = ea[3]; i1 = 3; }
                if (eb[0] > m1) { m1 = eb[0]; i1 = 4; } if (eb[1] > m1) { m1 = eb[1]; i1 = 5; } if (eb[2] > m1) { m1 = eb[2]; i1 = 6; } if (eb[3] > m1) { m1 = eb[3]; i1 = 7; }
                int i2 = -1; float m2 = -INFINITY;
                if (i1 != 0 && ea[0] > m2) { m2 = ea[0]; i2 = 0; } if (i1 != 1 && ea[1] > m2) { m2 = ea[1]; i2 = 1; } if (i1 != 2 && ea[2] > m2) { m2 = ea[2]; i2 = 2; } if (i1 != 3 && ea[3] > m2) { m2 = ea[3]; i2 = 3; }
                if (i1 != 4 && eb[0] > m2) { m2 = eb[0]; i2 = 4; } if (i1 != 5 && eb[1] > m2) { m2 = eb[1]; i2 = 5; } if (i1 != 6 && eb[2] > m2) { m2 = eb[2]; i2 = 6; } if (i1 != 7 && eb[3] > m2) { m2 = eb[3]; i2 = 7; }
                if (fq == gi) {
                    const float r = expf(m2 - m1);
                    const int e0 = fq * EPG + i1, e1 = fq * EPG + i2;
                    EIDX[row * 2] = e0; EIDX[row * 2 + 1] = e1; EW[row * 2] = gval / (1.0f + r); EW[row * 2 + 1] = gval * r / (1.0f + r);
                    ebuf[rloc * 2] = e0; ebuf[rloc * 2 + 1] = e1;
                }
                if (m & 1) asm volatile("" ::: "memory");
            }
    }
};
struct OneUnit {
    Unit u;
    __device__ __forceinline__ bool next(int i, Unit& o) const { if (i != 0) return false; o = u; return true; }
    __device__ __forceinline__ void a_ready(const Unit&) const {}
    __device__ __forceinline__ void done(const Unit&) const {}
};
struct EpiGateUp {
    static constexpr bool PERM = true, HAS_INIT = false, HAS_MIDK = false;
    const float* SLOTRS; bf16_t* HID;
    __device__ __forceinline__ void operator()(const f32x4 (&acc)[2][2][4][2], const Unit& u, int wr, int wc, int fr, int fq) const {
        const int pnl = u.pn & 1; const int slot0 = u.pm * 256 + wr * 64 + fr;
        float rsv[8];
#pragma unroll
        for (int i = 0; i < 8; ++i) rsv[i] = SLOTRS[slot0 + (i >> 2) * 128 + (i & 3) * 16];
        const bool odd = fq & 1;
        int rowv = slot0 + (odd ? 16 : 0);
#pragma unroll
        for (int ai = 0; ai < 2; ++ai)
#pragma unroll
            for (int j = 0; j < 2; ++j) {
                asm volatile("" : "+v"(rowv)); const int slot = rowv; rowv += (j == 1) ? 96 : 32; const float rs0 = rsv[ai * 4 + 2 * j], rs1 = rsv[ai * 4 + 2 * j + 1];
#pragma unroll
                for (int bj = 0; bj < 2; ++bj) { const int hc = pnl * 128 + bj * 64 + wc * 16 + 4 * (fq & 2);
                    const f32x4 gt0 = acc[ai][bj][2 * j][0] * rs0, up0 = acc[ai][bj][2 * j][1] * rs0, gt1 = acc[ai][bj][2 * j + 1][0] * rs1, up1 = acc[ai][bj][2 * j + 1][1] * rs1; f32x4 h0, h1;
#pragma unroll
                    for (int i = 0; i < 4; ++i) { h0[i] = gt0[i] * up0[i] * __builtin_amdgcn_rcpf(1.0f + __builtin_amdgcn_exp2f(-gt0[i] * LOG2E)); h1[i] = gt1[i] * up1[i] * __builtin_amdgcn_rcpf(1.0f + __builtin_amdgcn_exp2f(-gt1[i] * LOG2E)); }
                    const unsigned A0 = cvt_pk_bf16(h0[0], h0[1]), A1 = cvt_pk_bf16(h0[2], h0[3]), B0 = cvt_pk_bf16(h1[0], h1[1]), B1 = cvt_pk_bf16(h1[2], h1[3]);
                    const unsigned r0 = (unsigned)__shfl_xor((int)(odd ? A0 : B0), 16), r1 = (unsigned)__shfl_xor((int)(odd ? A1 : B1), 16);
                    const u32x4 o = {odd ? r0 : A0, odd ? r1 : A1, odd ? B0 : r0, odd ? B1 : r1};
                    *(u32x4*)(HID + (size_t)slot * 256 + hc) = o; }
            }
    }
};
struct EpiDown {
    static constexpr bool PERM = true, HAS_INIT = false, HAS_MIDK = false;
    const int* SLOTTOK; const float* SLOTW; unsigned char* YB;
    __device__ __forceinline__ void operator()(const f32x4 (&acc)[2][2][4][2], const Unit& u, int wr, int wc, int fr, int fq) const {
        const int pnl = u.pn & 3; const int slot0 = u.pm * 256 + wr * 64 + fr;
        int st[8]; float wv[8];
#pragma unroll
        for (int i = 0; i < 8; ++i) { st[i] = SLOTTOK[slot0 + (i >> 2) * 128 + (i & 3) * 16]; wv[i] = SLOTW[slot0 + (i >> 2) * 128 + (i & 3) * 16] * YB_SCALE; }
        const bool odd = fq & 1;
#pragma unroll
        for (int ai = 0; ai < 2; ++ai)
#pragma unroll
            for (int j = 0; j < 2; ++j) {
                const int i0 = ai * 4 + 2 * j, i1 = i0 + 1;
                const int sti = odd ? st[i1] : st[i0];
#pragma unroll
                for (int bj = 0; bj < 2; ++bj) {
                    const f32x4 a0 = acc[ai][bj][2 * j][0] * wv[i0], b0 = acc[ai][bj][2 * j][1] * wv[i0], a1 = acc[ai][bj][2 * j + 1][0] * wv[i1], b1 = acc[ai][bj][2 * j + 1][1] * wv[i1];
                    int A_lo = __builtin_amdgcn_cvt_pk_fp8_f32(a0[0], a0[1], 0, false); A_lo = __builtin_amdgcn_cvt_pk_fp8_f32(a0[2], a0[3], A_lo, true);
                    int A_hi = __builtin_amdgcn_cvt_pk_fp8_f32(b0[0], b0[1], 0, false); A_hi = __builtin_amdgcn_cvt_pk_fp8_f32(b0[2], b0[3], A_hi, true);
                    int B_lo = __builtin_amdgcn_cvt_pk_fp8_f32(a1[0], a1[1], 0, false); B_lo = __builtin_amdgcn_cvt_pk_fp8_f32(a1[2], a1[3], B_lo, true);
                    int B_hi = __builtin_amdgcn_cvt_pk_fp8_f32(b1[0], b1[1], 0, false); B_hi = __builtin_amdgcn_cvt_pk_fp8_f32(b1[2], b1[3], B_hi, true);
                    const int r_lo = __shfl_xor(odd ? A_lo : B_lo, 16), r_hi = __shfl_xor(odd ? A_hi : B_hi, 16);
                    const u32x4 o = {(unsigned)(odd ? r_lo : A_lo), (unsigned)(odd ? r_hi : A_hi), (unsigned)(odd ? B_lo : r_lo), (unsigned)(odd ? B_hi : r_hi)};
                    if (sti >= 0) *(u32x4*)(YB + (size_t)sti * 1024 + pnl * 256 + bj * 128 + wc * 32 + 8 * (fq & 2)) = o;
                }
            }
    }
};
struct MoeOrder {
    const int* tile_e; int ntiles, npn, G, c; int lim;
    __device__ __forceinline__ bool next(int i, Unit& u) const {
        const int L = i * G + c; if (L >= lim) return false;
        const int tile = L / npn, pn = L - tile * npn; u.pm = tile; u.pn = tile_e[tile] * npn + pn; return true;
    }
    __device__ __forceinline__ void a_ready(const Unit&) const {}
    __device__ __forceinline__ void done(const Unit&) const {}
};
struct LateOrder {
    const int* tile_e; int ntiles, G, c, nlate, tile0; unsigned* cnt; unsigned* tmo;
    __device__ __forceinline__ bool next(int i, Unit& u) const {
        const int NL = G - nlate; int L;
        if (c < nlate) L = 2 * NL + i * G + c; else L = (i < 2) ? i * NL + (c - nlate) : 2 * NL + (i - 2) * G + c;
        if (L >= ntiles * 4) return false;
        const int tile = L >> 2, pn = L & 3; u.pm = tile; u.pn = tile_e[tile] * 4 + pn; return true;
    }
    __device__ __forceinline__ void a_ready(const Unit& u) const {
        if (u.pm < tile0) return;
        if (__builtin_amdgcn_readfirstlane((int)threadIdx.x >> 6) == 0) {
            unsigned* w = cnt + 64 * (u.pm - tile0); unsigned sp = 0u;
            while ((unsigned)__builtin_amdgcn_readfirstlane((int)__hip_atomic_load(w, __ATOMIC_RELAXED, __HIP_MEMORY_SCOPE_AGENT)) < 2u) {
                __builtin_amdgcn_s_sleep(2);
                if (++sp > (1u << 22)) { if ((threadIdx.x & 63) == 0) __hip_atomic_store(tmo, 1u, __ATOMIC_RELAXED, __HIP_MEMORY_SCOPE_AGENT); break; }
            }
            __builtin_amdgcn_fence(__ATOMIC_ACQUIRE, "agent");
        }
        asm volatile("s_waitcnt vmcnt(0) lgkmcnt(0)" ::: "memory"); __builtin_amdgcn_s_barrier(); asm volatile("" ::: "memory");
    }
    __device__ __forceinline__ void done(const Unit&) const {}
};
}

#ifndef SB_EARLY_EXIT
#define SB_EARLY_EXIT 1
#endif
#ifndef SB_EXIT_R
#define SB_EXIT_R 0x1p-40f
#endif
namespace att {
typedef __attribute__((address_space(3))) unsigned char l8;
typedef short bf16x8 __attribute__((ext_vector_type(8)));
typedef short s16x4 __attribute__((ext_vector_type(4)));
typedef float f32x16 __attribute__((ext_vector_type(16)));
typedef float f32x4 __attribute__((ext_vector_type(4)));
typedef unsigned u32x4 __attribute__((ext_vector_type(4)));
typedef unsigned short bf16_t;
constexpr int SLOT_K = 12288, SLOT_V = 8192;
constexpr int L_K = 0, L_V = 2 * SLOT_K, L_WS = L_V + 2 * SLOT_V, L_FLAG = L_WS + 8 * 256, L_OST = L_FLAG + 256, L_END = L_OST + 8 * 4096;
__device__ __forceinline__ int crow(int r, int hi) { return (r & 3) + 8 * (r >> 2) + 4 * hi; }
__device__ __forceinline__ void glds16(const void* gsrc, unsigned lds_dst) { unsigned keep;
    asm volatile("s_mov_b32 %0, m0\n\ts_mov_b32 m0, %2\n\ts_nop 0\n\tglobal_load_lds_dwordx4 %1, off\n\ts_mov_b32 m0, %0" : "=&s"(keep) : "v"(gsrc), "s"(lds_dst) : "memory"); }
__device__ __forceinline__ void glds16s(const void* sbase, unsigned voff, unsigned lds_dst) { unsigned keep;
    asm volatile("s_mov_b32 %0, m0\n\ts_mov_b32 m0, %3\n\ts_nop 4\n\tglobal_load_lds_dwordx4 %1, %2\n\ts_mov_b32 m0, %0" : "=&s"(keep) : "v"(voff), "s"(sbase), "s"(lds_dst) : "memory"); }
__device__ __forceinline__ unsigned cvtpk(float lo, float hi) { return pg8::cvt_pk_bf16(lo, hi); }
__device__ __forceinline__ s16x4 vtr(const l8* p) { typedef short v4i16_t __attribute__((ext_vector_type(4)));
    return __builtin_bit_cast(s16x4, __builtin_amdgcn_ds_read_tr16_b64_v4i16((__attribute__((address_space(3))) v4i16_t*)p)); }
__device__ __forceinline__ float bf2f(unsigned short b) { return __builtin_bit_cast(float, (unsigned)b << 16); }
#define ATT_WAIT_BAR() asm volatile("s_waitcnt vmcnt(0) lgkmcnt(0)\n\ts_barrier" ::: "memory")

struct Tensors { const bf16_t* Q; int qp, qh;
                 const bf16_t* K; int kp, kh;
                 const bf16_t* KR;
                 const bf16_t* V; int vp, vh;
                 bf16_t* O; int ocol;
                 float* OSS; int ossc; };

constexpr int SBS = 16384, SB_NS = 7, SB_AHEAD = 3, SB_FLAG = SB_NS * SBS, SB_OST = SB_FLAG + 64;
__device__ __forceinline__ void sb_unit(l8* shm, int bh, int qb, const Tensors& P, int& lo) {
    const int tid = threadIdx.x, lane = tid & 63, r32 = lane & 31, hi = lane >> 5; const int wid = __builtin_amdgcn_readfirstlane(tid >> 6);
    const int b = bh >> 3, h = bh & 7; const long rowbase = (long)b * SEQ; const int q0 = qb * 256, a = q0 + 32 * wid, J = q0 >> 6;
    const unsigned lds0 = (unsigned)(uintptr_t)shm;
    __attribute__((address_space(3))) unsigned* flg = (__attribute__((address_space(3))) unsigned*)(shm + SB_FLAG);
    const bf16_t* kbase = P.K + rowbase * P.kp + h * P.kh + wid * 8;
    const bf16_t* vbase = P.V + (rowbase + 16 * (wid & 3)) * P.vp + h * P.vh + (wid >> 2) * 32;
    const unsigned koff = (unsigned)(lane * P.kp * 2), voffl = (unsigned)(((lane >> 2) * P.vp + (lane & 3) * 8) * 2);
#define SB_DMA(t) do { const int sl_ = (t) % SB_NS; \
        glds16s(kbase + (long)(t) * 64 * P.kp, koff, (unsigned)__builtin_amdgcn_readfirstlane(lds0 + sl_ * SBS + wid * 1024)); \
        glds16s(vbase + (long)(t) * 64 * P.vp, voffl, (unsigned)__builtin_amdgcn_readfirstlane(lds0 + sl_ * SBS + 8192 + wid * 1024)); } while (0)
    if (lo < J - 3) lo = 1 << 20;
    { const int tl = (J - (SB_AHEAD - 1) > 0) ? J - (SB_AHEAD - 1) : 0;
      for (int t = (lo - 1 < J + 3 ? lo - 1 : J + 3); t >= tl; --t) SB_DMA(t);
      if (lo > tl) lo = tl; }
    if (lane < 2) flg[lane * 8 + wid] = 0u;
    bf16x8 qr[4];
    { const bf16_t* qw = P.Q + (rowbase + a + r32) * P.qp + h * P.qh + hi * 8;
#pragma unroll
      for (int c2 = 0; c2 < 4; ++c2) qr[c2] = *(const bf16x8*)(qw + c2 * 16); }
    asm volatile("s_waitcnt vmcnt(0)" ::: "memory");
#pragma unroll
    for (int c2 = 0; c2 < 4; ++c2) asm volatile("" : "+v"(qr[c2]));
    f32x16 o0 = {}, o1 = {};
    float R = 1.0f; bool done = false;
    const int vb = ((lane >> 4) & 1) * 32 + (lane & 3) * 8 + (4 * hi + ((lane & 15) >> 2)) * 64;
    int tw = J + (wid >> 1);
    for (int it = 0; it < J + 4; ++it, --tw) {
        ATT_WAIT_BAR();
        if (SB_EARLY_EXIT && it > 0) {
            const __attribute__((address_space(3))) unsigned* f = flg + ((it - 1) & 1) * 8;
            const unsigned all = f[0] & f[1] & f[2] & f[3] & f[4] & f[5] & f[6] & f[7];
            if (__builtin_amdgcn_readfirstlane(all) != 0u) break;
        }
        if (J - it - SB_AHEAD >= 0 && J - it - SB_AHEAD < lo) { SB_DMA(J - it - SB_AHEAD); lo = J - it - SB_AHEAD; }
        if (tw < 0) done = true;
        if (!done) {
            const int sl = tw % SB_NS;
            const l8* ks = shm + sl * SBS + hi * 1024 + r32 * 16;
            f32x16 p0 = {}, p1 = {};
#pragma unroll
            for (int c2 = 0; c2 < 4; ++c2) {
                const bf16x8 k0 = *(const __attribute__((address_space(3))) bf16x8*)(ks + c2 * 2048), k1 = *(const __attribute__((address_space(3))) bf16x8*)(ks + c2 * 2048 + 512);
                p0 = __builtin_amdgcn_mfma_f32_32x32x16_bf16(k0, qr[c2], p0, 0, 0, 0);
                p1 = __builtin_amdgcn_mfma_f32_32x32x16_bf16(k1, qr[c2], p1, 0, 0, 0);
            }
            if (it == 0) {
                const int tqh = a + r32 - 64 * tw - 1 - 4 * hi;
#pragma unroll
                for (int r = 0; r < 16; ++r) { const int kc = (r & 3) + 8 * (r >> 2); if (kc > tqh) p0[r] = -INFINITY; if (kc + 32 > tqh) p1[r] = -INFINITY; }
            }
            unsigned pw[16];
            float bt0[16], bt1[16];
#pragma unroll
            for (int r = 0; r < 16; ++r) {
                const float e0 = __builtin_amdgcn_exp2f(fminf(p0[r], 100.f)), e1 = __builtin_amdgcn_exp2f(fminf(p1[r], 100.f));
                const float i0 = __builtin_amdgcn_rcpf(1.0f + e0), i1 = __builtin_amdgcn_rcpf(1.0f + e1);
                p0[r] = i0; p1[r] = i1; bt0[r] = e0 * i0; bt1[r] = e1 * i1;
            }
            float RE = R;
#pragma unroll
            for (int g = 7; g >= 0; --g) {
                float r0, r1, r2, r3, b0, b1, b2, b3;
                if (g >= 4) { r0 = p1[4 * (g - 4)]; r1 = p1[4 * (g - 4) + 1]; r2 = p1[4 * (g - 4) + 2]; r3 = p1[4 * (g - 4) + 3]; b0 = bt1[4 * (g - 4)]; b1 = bt1[4 * (g - 4) + 1]; b2 = bt1[4 * (g - 4) + 2]; b3 = bt1[4 * (g - 4) + 3]; }
                else { r0 = p0[4 * g]; r1 = p0[4 * g + 1]; r2 = p0[4 * g + 2]; r3 = p0[4 * g + 3]; b0 = bt0[4 * g]; b1 = bt0[4 * g + 1]; b2 = bt0[4 * g + 2]; b3 = bt0[4 * g + 3]; }
                const float w2 = r3, w1 = w2 * r2, w0 = w1 * r1, G = w0 * r0;
                auto sw = __builtin_amdgcn_permlane32_swap(__float_as_uint(G), __float_as_uint(G), false, false);
                const float g0 = __uint_as_float(sw[0]), g1 = __uint_as_float(sw[1]);
                const float Mx = RE * (hi ? 1.0f : g1);
                const float a3 = b3 * Mx, a2 = b2 * w2 * Mx, a1 = b1 * w1 * Mx, a0 = b0 * w0 * Mx;
                pw[2 * g] = cvtpk(a0, a1); pw[2 * g + 1] = cvtpk(a2, a3);
                RE *= g0 * g1;
            }
            R = RE;
            if (SB_EARLY_EXIT) done = __all(R < SB_EXIT_R);
            const l8* vs = shm + sl * SBS + 8192 + vb;
#pragma unroll
            for (int ks2 = 0; ks2 < 4; ++ks2) {
                const bf16x8 pa = __builtin_bit_cast(bf16x8, (u32x4){pw[4 * ks2], pw[4 * ks2 + 1], pw[4 * ks2 + 2], pw[4 * ks2 + 3]});
                { const s16x4 lo_ = vtr(vs + ks2 * 1024), hh = vtr(vs + ks2 * 1024 + 512);
                  o0 = __builtin_amdgcn_mfma_f32_32x32x16_bf16(pa, (bf16x8){lo_[0], lo_[1], lo_[2], lo_[3], hh[0], hh[1], hh[2], hh[3]}, o0, 0, 0, 0); }
                { const s16x4 lo_ = vtr(vs + 4096 + ks2 * 1024), hh = vtr(vs + 4096 + ks2 * 1024 + 512);
                  o1 = __builtin_amdgcn_mfma_f32_32x32x16_bf16(pa, (bf16x8){lo_[0], lo_[1], lo_[2], lo_[3], hh[0], hh[1], hh[2], hh[3]}, o1, 0, 0, 0); }
            }
        }
        if (lane == 0) flg[(it & 1) * 8 + wid] = done ? 1u : 0u;
    }
    int lane_e = lane; asm volatile("" : "+v"(lane_e));
    const int r32e = lane_e & 31, hie = lane_e >> 5;
    { __attribute__((address_space(3))) bf16_t* stg = (__attribute__((address_space(3))) bf16_t*)(shm + SB_OST) + wid * 1024;
      bf16_t* ow = P.O + (rowbase + a) * 1024 + P.ocol + h * 64;
      float sq[2] = {0.f, 0.f};
#pragma unroll
      for (int dh = 0; dh < 2; ++dh) {
#pragma unroll
          for (int r = 0; r < 16; ++r) stg[crow(r, hie) * 32 + r32e] = (bf16_t)(cvtpk(dh ? o1[r] : o0[r], 0.f) & 0xffffu);
          asm volatile("s_waitcnt lgkmcnt(0)" ::: "memory");
#pragma unroll
          for (int i = 0; i < 2; ++i) { const int row = i * 16 + (lane_e >> 2), ch = lane_e & 3;
              const u32x4 v = *(const __attribute__((address_space(3))) u32x4*)(stg + row * 32 + ch * 8);
              *(u32x4*)(ow + (long)row * 1024 + dh * 32 + ch * 8) = v;
#pragma unroll
              for (int e = 0; e < 4; ++e) { const float x0 = __builtin_bit_cast(float, v[e] << 16), x1 = __builtin_bit_cast(float, v[e] & 0xffff0000u); sq[i] += x0 * x0 + x1 * x1; } }
          asm volatile("s_waitcnt lgkmcnt(0)" ::: "memory");
      }
#pragma unroll
      for (int i = 0; i < 2; ++i) { float s_ = sq[i]; s_ += __shfl_xor(s_, 1); s_ += __shfl_xor(s_, 2);
          if ((lane_e & 3) == 0) P.OSS[(rowbase + a + i * 16 + (lane_e >> 2)) * 16 + P.ossc + h] = s_; } }
    ATT_WAIT_BAR();
#undef SB_DMA
}
template <int MODE>
__device__ __forceinline__ void attn_unit(l8* shm, int bh, int qb, const Tensors& P, const bool pre, const bool nxt) {
    constexpr int NC2 = MODE ? 6 : 4;
    const int tid = threadIdx.x, lane = tid & 63, r32 = lane & 31, hi = lane >> 5; const int wid = __builtin_amdgcn_readfirstlane(tid >> 6);
    const int b = bh >> 3, h = bh & 7; const long rowbase = (long)b * SEQ; const int q0 = qb * 512, a = q0 + 64 * wid;
    const unsigned lds0 = (unsigned)(uintptr_t)shm;
    __attribute__((address_space(3))) float* wsf = (__attribute__((address_space(3))) float*)(shm + L_WS) + wid * 64;
    __attribute__((address_space(3))) unsigned* flg = (__attribute__((address_space(3))) unsigned*)(shm + L_FLAG);
    const int NT = (q0 + 512) / 64;
    const bf16_t* kbase = P.K + rowbase * P.kp + h * P.kh + wid * 8;
    const bf16_t* krbase = MODE ? P.KR + rowbase * ROPE + (wid & 3) * 8 : nullptr;
    const bf16_t* vbase = P.V + (rowbase + 16 * (wid & 3)) * P.vp + h * P.vh + (wid >> 2) * 32;
    const unsigned koff = (unsigned)(lane * P.kp * 2), kroff = (unsigned)(lane * ROPE * 2), voffl = (unsigned)(((lane >> 2) * P.vp + (lane & 3) * 8) * 2);
#define ATT_DMA(j, s) do { \
        glds16s(kbase + (long)(j) * 64 * P.kp, koff, (unsigned)__builtin_amdgcn_readfirstlane(lds0 + L_K + (s) * SLOT_K + wid * 1024)); \
        if (MODE && wid < 4) glds16s(krbase + (long)(j) * 64 * ROPE, kroff, (unsigned)__builtin_amdgcn_readfirstlane(lds0 + L_K + (s) * SLOT_K + (8 + wid) * 1024)); \
        glds16s(vbase + (long)(j) * 64 * P.vp, voffl, (unsigned)__builtin_amdgcn_readfirstlane(lds0 + L_V + (s) * SLOT_V + wid * 1024)); } while (0)
    if (!pre) ATT_DMA(NT - 1, 0);
    if (lane < 2) flg[lane * 8 + wid] = 0u;
    bf16x8 qr[2][NC2];
#pragma unroll
    for (int z = 0; z < 2; ++z) { const bf16_t* qw = P.Q + (rowbase + a + 32 * z + r32) * P.qp + h * P.qh + hi * 8;
#pragma unroll
        for (int c2 = 0; c2 < NC2; ++c2) qr[z][c2] = *(const bf16x8*)(qw + c2 * 16); }
    asm volatile("s_waitcnt vmcnt(0)" ::: "memory");
#pragma unroll
    for (int z = 0; z < 2; ++z)
#pragma unroll
        for (int c2 = 0; c2 < NC2; ++c2) asm volatile("" : "+v"(qr[z][c2]));
    f32x16 o0[2] = {{}, {}}, o1[2] = {{}, {}};
    float m_run[2] = {-1e30f, -1e30f}, l_run[2] = {0.f, 0.f}, R[2] = {1.0f, 1.0f}; bool done = false;
    const int vb = ((lane >> 4) & 1) * 32 + (lane & 3) * 8 + (4 * hi + ((lane & 15) >> 2)) * 64;
    for (int it = 0; it < NT; ++it) {
        const int j = NT - 1 - it, s = it & 1;
        ATT_WAIT_BAR();
        if (MODE == 0 && SB_EARLY_EXIT && it > 0) {
            const __attribute__((address_space(3))) unsigned* f = flg + ((it - 1) & 1) * 8;
            unsigned all = f[0] & f[1] & f[2] & f[3] & f[4] & f[5] & f[6] & f[7];
            if (__builtin_amdgcn_readfirstlane(all) != 0u) { if (nxt) ATT_DMA(NT - 9, 0); break; }
        }
        if (it + 1 < NT) ATT_DMA(j - 1, s ^ 1); else if (nxt) ATT_DMA(NT - 9, 0);
        if (64 * j <= a && !done) {
            const l8* ks = shm + L_K + s * SLOT_K + hi * 1024 + r32 * 16;
            f32x16 p0[2] = {{}, {}}, p1[2] = {{}, {}};
#pragma unroll
            for (int c2 = 0; c2 < NC2; ++c2) {
                const bf16x8 k0 = *(const __attribute__((address_space(3))) bf16x8*)(ks + c2 * 2048), k1 = *(const __attribute__((address_space(3))) bf16x8*)(ks + c2 * 2048 + 512);
#pragma unroll
                for (int z = 0; z < 2; ++z) { p0[z] = __builtin_amdgcn_mfma_f32_32x32x16_bf16(k0, qr[z][c2], p0[z], 0, 0, 0); p1[z] = __builtin_amdgcn_mfma_f32_32x32x16_bf16(k1, qr[z][c2], p1[z], 0, 0, 0); }
            }
            if (64 * j == a) {
#pragma unroll
                for (int z = 0; z < 2; ++z) { const int tqh = 32 * z + r32 - (MODE ? 0 : 1) - 4 * hi;
#pragma unroll
                    for (int r = 0; r < 16; ++r) { const int kc = (r & 3) + 8 * (r >> 2); if (kc > tqh) p0[z][r] = -INFINITY; if (kc + 32 > tqh) p1[z][r] = -INFINITY; } }
            }
            unsigned pw[2][16];
#pragma unroll
            for (int z = 0; z < 2; ++z) {
              if (MODE == 1) {
                float rm = fmaxf(p0[z][0], p1[z][0]);
#pragma unroll
                for (int r = 1; r < 16; ++r) rm = fmaxf(fmaxf(rm, p0[z][r]), p1[z][r]);
                { auto rr = __builtin_amdgcn_permlane32_swap(__float_as_uint(rm), __float_as_uint(rm), false, false); rm = fmaxf(__uint_as_float(rr[0]), __uint_as_float(rr[1])); }
                if (__any(rm > m_run[z] + 8.0f)) {
                    const float mn = fmaxf(m_run[z], rm), alpha = __builtin_amdgcn_exp2f(m_run[z] - mn); m_run[z] = mn; l_run[z] *= alpha;
                    if (hi == 0) wsf[32 * z + r32] = alpha;
#pragma unroll
                    for (int g = 0; g < 4; ++g) { const f32x4 al = *(const __attribute__((address_space(3))) f32x4*)(wsf + 32 * z + 8 * g + 4 * hi);
#pragma unroll
                        for (int i = 0; i < 4; ++i) { o0[z][4 * g + i] *= al[i]; o1[z][4 * g + i] *= al[i]; } }
                }
                float ls = 0.f;
#pragma unroll
                for (int r = 0; r < 16; ++r) { p0[z][r] = __builtin_amdgcn_exp2f(p0[z][r] - m_run[z]); p1[z][r] = __builtin_amdgcn_exp2f(p1[z][r] - m_run[z]); ls += p0[z][r] + p1[z][r]; }
                l_run[z] += ls;
#pragma unroll
                for (int r = 0; r < 8; ++r) { pw[z][r] = cvtpk(p0[z][2 * r], p0[z][2 * r + 1]); pw[z][8 + r] = cvtpk(p1[z][2 * r], p1[z][2 * r + 1]); }
              } else {
                float bt0[16], bt1[16];
#pragma unroll
                for (int r = 0; r < 16; ++r) {
                    const float e0 = __builtin_amdgcn_exp2f(fminf(p0[z][r], 100.f)), e1 = __builtin_amdgcn_exp2f(fminf(p1[z][r], 100.f));
                    const float i0 = __builtin_amdgcn_rcpf(1.0f + e0), i1 = __builtin_amdgcn_rcpf(1.0f + e1);
                    p0[z][r] = i0; p1[z][r] = i1; bt0[r] = e0 * i0; bt1[r] = e1 * i1;
                }
                float RE = R[z];
#pragma unroll
                for (int g = 7; g >= 0; --g) {
                    float r0, r1, r2, r3, b0, b1, b2, b3;
                    if (g >= 4) { r0 = p1[z][4 * (g - 4)]; r1 = p1[z][4 * (g - 4) + 1]; r2 = p1[z][4 * (g - 4) + 2]; r3 = p1[z][4 * (g - 4) + 3]; b0 = bt1[4 * (g - 4)]; b1 = bt1[4 * (g - 4) + 1]; b2 = bt1[4 * (g - 4) + 2]; b3 = bt1[4 * (g - 4) + 3]; }
                    else { r0 = p0[z][4 * g]; r1 = p0[z][4 * g + 1]; r2 = p0[z][4 * g + 2]; r3 = p0[z][4 * g + 3]; b0 = bt0[4 * g]; b1 = bt0[4 * g + 1]; b2 = bt0[4 * g + 2]; b3 = bt0[4 * g + 3]; }
                    const float w2 = r3, w1 = w2 * r2, w0 = w1 * r1, G = w0 * r0;
                    auto sw = __builtin_amdgcn_permlane32_swap(__float_as_uint(G), __float_as_uint(G), false, false);
                    const float g0 = __uint_as_float(sw[0]), g1 = __uint_as_float(sw[1]);
                    const float Mx = RE * (hi ? 1.0f : g1);
                    const float a3 = b3 * Mx, a2 = b2 * w2 * Mx, a1 = b1 * w1 * Mx, a0 = b0 * w0 * Mx;
                    pw[z][2 * g] = cvtpk(a0, a1); pw[z][2 * g + 1] = cvtpk(a2, a3);
                    RE *= g0 * g1;
                }
                R[z] = RE;
              }
            }
            if (MODE == 0 && SB_EARLY_EXIT) done = __all(fmaxf(R[0], R[1]) < SB_EXIT_R);
            const l8* vs = shm + L_V + s * SLOT_V + vb;
#pragma unroll
            for (int ks2 = 0; ks2 < 4; ++ks2) {
                bf16x8 vf0, vf1;
                { const s16x4 lo = vtr(vs + ks2 * 1024), hh = vtr(vs + ks2 * 1024 + 512); vf0 = (bf16x8){lo[0], lo[1], lo[2], lo[3], hh[0], hh[1], hh[2], hh[3]}; }
                { const s16x4 lo = vtr(vs + 4096 + ks2 * 1024), hh = vtr(vs + 4096 + ks2 * 1024 + 512); vf1 = (bf16x8){lo[0], lo[1], lo[2], lo[3], hh[0], hh[1], hh[2], hh[3]}; }
#pragma unroll
                for (int z = 0; z < 2; ++z) {
                    const bf16x8 pa = __builtin_bit_cast(bf16x8, (u32x4){pw[z][4 * ks2], pw[z][4 * ks2 + 1], pw[z][4 * ks2 + 2], pw[z][4 * ks2 + 3]});
                    o0[z] = __builtin_amdgcn_mfma_f32_32x32x16_bf16(pa, vf0, o0[z], 0, 0, 0);
                    o1[z] = __builtin_amdgcn_mfma_f32_32x32x16_bf16(pa, vf1, o1[z], 0, 0, 0);
                }
            }
        }
        if (MODE == 0 && SB_EARLY_EXIT) { if (lane == 0) flg[s * 8 + wid] = done ? 1u : 0u; }
    }
    int lane_e = lane; asm volatile("" : "+v"(lane_e));
    const int r32e = lane_e & 31, hie = lane_e >> 5;
#pragma unroll
    for (int z = 0; z < 2; ++z) {
        if (MODE == 1) {
            float l = l_run[z];
            { auto rr = __builtin_amdgcn_permlane32_swap(__float_as_uint(l), __float_as_uint(l), false, false); l = __uint_as_float(rr[0]) + __uint_as_float(rr[1]); }
            if (hie == 0) wsf[r32e] = __builtin_amdgcn_rcpf(l);
#pragma unroll
            for (int g = 0; g < 4; ++g) { const f32x4 il = *(const __attribute__((address_space(3))) f32x4*)(wsf + 8 * g + 4 * hie);
#pragma unroll
                for (int i = 0; i < 4; ++i) { o0[z][4 * g + i] *= il[i]; o1[z][4 * g + i] *= il[i]; } }
        }
        __attribute__((address_space(3))) bf16_t* stg = (__attribute__((address_space(3))) bf16_t*)(shm + L_OST) + wid * 2048;
#pragma unroll
        for (int r = 0; r < 16; ++r) { const int orow = crow(r, hie);
            stg[orow * 64 + r32e] = (bf16_t)(cvtpk(o0[z][r], 0.f) & 0xffffu); stg[orow * 64 + 32 + r32e] = (bf16_t)(cvtpk(o1[z][r], 0.f) & 0xffffu); }
        asm volatile("s_waitcnt lgkmcnt(0)" ::: "memory");
        bf16_t* ow = P.O + (rowbase + a + 32 * z) * 1024 + P.ocol + h * 64;
#pragma unroll
        for (int i = 0; i < 4; ++i) { const int row = i * 8 + (lane_e >> 3), ch = lane_e & 7;
            const u32x4 v = *(const __attribute__((address_space(3))) u32x4*)(stg + row * 64 + ch * 8);
            __builtin_nontemporal_store(v, (u32x4*)(ow + (long)row * 1024 + ch * 8));
            float sq = 0.f;
#pragma unroll
            for (int e = 0; e < 4; ++e) { const float x0 = __builtin_bit_cast(float, v[e] << 16), x1 = __builtin_bit_cast(float, v[e] & 0xffff0000u); sq += x0 * x0 + x1 * x1; }
            sq += __shfl_xor(sq, 1); sq += __shfl_xor(sq, 2); sq += __shfl_xor(sq, 4);
            if (ch == 0) P.OSS[(rowbase + a + 32 * z + row) * 16 + P.ossc + h] = sq; }
        asm volatile("s_waitcnt lgkmcnt(0)" ::: "memory");
    }
    ATT_WAIT_BAR();
#undef ATT_DMA
}
}

__device__ __forceinline__ float wave_sum(float v) {
#pragma unroll
    for (int o = 1; o < 64; o <<= 1) v += __shfl_xor(v, o);
    return v;
}
__device__ __forceinline__ float bflo(unsigned w) { return __builtin_bit_cast(float, w << 16); }
__device__ __forceinline__ float bfhi(unsigned w) { return __builtin_bit_cast(float, w & 0xffff0000u); }

template <class V> __device__ __forceinline__ void tr_load(const V& val, int nblk, int item, int lane, float (&tv)[32]) {
    const int kb = item / nblk, nb = item - kb * nblk, k0 = 64 * kb, n0 = 32 * nb;
#pragma unroll
    for (int i = 0; i < 32; ++i) tv[i] = val(k0 + 2 * i + (lane >> 5), n0 + (lane & 31));
}
__device__ __forceinline__ void tr_store(const float (&tv)[32], int K, int nblk, bf16* WT, LAS float* scr, int item, int lane) {
    const int kb = item / nblk, nb = item - kb * nblk, k0 = 64 * kb, n0 = 32 * nb;
#pragma unroll
    for (int i = 0; i < 32; ++i) scr[(2 * i + (lane >> 5)) * 33 + (lane & 31)] = tv[i];
    LDS_WAIT(); asm volatile("" ::: "memory");
    const int c = lane & 7;
#pragma unroll
    for (int j = 0; j < 4; ++j) { const int n = (lane >> 3) + 8 * j; const LAS float* s = scr + (8 * c) * 33 + n;
        v4u o; o.x = pk2(s[0 * 33], s[1 * 33]); o.y = pk2(s[2 * 33], s[3 * 33]); o.z = pk2(s[4 * 33], s[5 * 33]); o.w = pk2(s[6 * 33], s[7 * 33]);
        *(GAS v4u*)(WT + (size_t)(n0 + n) * K + k0 + 8 * c) = o; }
    LDS_WAIT(); asm volatile("" ::: "memory");
}
template <class V> __device__ __forceinline__ void tr_load4(const V& val, int nblk, int item, int lane, f32x4 (&tv)[8]) {
    const int kb = item / nblk, nb = item - kb * nblk, k0 = 64 * kb, n0 = 32 * nb;
#pragma unroll
    for (int i = 0; i < 8; ++i) tv[i] = val.v4(k0 + 8 * i + (lane >> 3), n0 + 4 * (lane & 7));
}
__device__ __forceinline__ void tr_store4(const f32x4 (&tv)[8], int K, int nblk, bf16* WT, LAS float* scr, int item, int lane) {
    const int kb = item / nblk, nb = item - kb * nblk, k0 = 64 * kb, n0 = 32 * nb;
#pragma unroll
    for (int i = 0; i < 8; ++i) { LAS float* d = scr + (8 * i + (lane >> 3)) * 33 + 4 * (lane & 7); d[0] = tv[i].x; d[1] = tv[i].y; d[2] = tv[i].z; d[3] = tv[i].w; }
    LDS_WAIT(); asm volatile("" ::: "memory");
    const int c = lane & 7;
#pragma unroll
    for (int j = 0; j < 4; ++j) { const int n = (lane >> 3) + 8 * j; const LAS float* s = scr + (8 * c) * 33 + n;
        v4u o; o.x = pk2(s[0 * 33], s[1 * 33]); o.y = pk2(s[2 * 33], s[3 * 33]); o.z = pk2(s[4 * 33], s[5 * 33]); o.w = pk2(s[6 * 33], s[7 * 33]);
        *(GAS v4u*)(WT + (size_t)(n0 + n) * K + k0 + 8 * c) = o; }
    LDS_WAIT(); asm volatile("" ::: "memory");
}
struct XwSrc { uintptr_t wg; long long dlt  ; uintptr_t wd, g, WGU, WD; };
constexpr int XW_GU1 = 16 * 16, XW_GU = NEXP * XW_GU1, XW_D1 = 4 * 32, XW_D = NEXP * XW_D1, XW_NI = XW_GU + XW_D;
__device__ __forceinline__ void xw_load(const XwSrc& S, int r, int lane, f32x4 (&tv)[8], float (&gk)[8]) {
    const bool gu = r < XW_GU; const int rr = gu ? r : r - XW_GU; const int e = gu ? (rr >> 8) : (rr >> 7); const int li = gu ? (rr & 255) : (rr & 127);
    const int kb = gu ? (li >> 4) : (li >> 5), nb = gu ? (li & 15) : (li & 31); const int k = 64 * kb + (lane >> 3), n = 32 * nb + 4 * (lane & 7);
    const uintptr_t bgu = S.wg + (uintptr_t)(((n >> 2) & 1) * S.dlt), base = (gu ? bgu : S.wd) + (uintptr_t)e * (DM * DEXP * 4);
    const int pitch = gu ? DEXP : DM; const int col = gu ? 4 * (n >> 3) : n;
    const GAS float* p = (const GAS float*)base + (size_t)k * pitch + col; const GAS float* gp = (const GAS float*)S.g + (gu ? k : (lane >> 3));
#pragma unroll
    for (int i = 0; i < 8; ++i) { tv[i] = *(const GAS f32x4*)(p + (size_t)(8 * i) * pitch); gk[i] = gp[8 * i]; }
}
__device__ __forceinline__ void xw_store(const XwSrc& S, int r, int lane, LAS float* scr, const f32x4 (&tv)[8], const float (&gk)[8]) {
    const bool gu = r < XW_GU; const int rr = gu ? r : r - XW_GU; const int e = gu ? (rr >> 8) : (rr >> 7); const int li = gu ? (rr & 255) : (rr & 127);
    const int kb = gu ? (li >> 4) : (li >> 5), nb = gu ? (li & 15) : (li & 31); const int k0 = 64 * kb, n0 = 32 * nb; const int K = gu ? DM : DEXP;
    bf16* WT = (bf16*)((gu ? S.WGU : S.WD) + (uintptr_t)e * (gu ? 512 * 1024 * 2 : 1024 * 256 * 2));
#pragma unroll
    for (int i = 0; i < 8; ++i) { const float gm = gu ? gk[i] : 1.0f; LAS float* d = scr + (8 * i + (lane >> 3)) * 33 + 4 * (lane & 7); d[0] = tv[i].x * gm; d[1] = tv[i].y * gm; d[2] = tv[i].z * gm; d[3] = tv[i].w * gm; }
    LDS_WAIT(); asm volatile("" ::: "memory");
    const int c = lane & 7;
#pragma unroll
    for (int j = 0; j < 4; ++j) { const int n = (lane >> 3) + 8 * j; const LAS float* s = scr + (8 * c) * 33 + n;
        v4u o; o.x = pk2(s[0 * 33], s[1 * 33]); o.y = pk2(s[2 * 33], s[3 * 33]); o.z = pk2(s[4 * 33], s[5 * 33]); o.w = pk2(s[6 * 33], s[7 * 33]);
        *(GAS v4u*)(WT + (size_t)(n0 + n) * K + k0 + 8 * c) = o; }
    LDS_WAIT(); asm volatile("" ::: "memory");
}
template <class V> __device__ __forceinline__ void tr_item(const V& val, int K, int nblk, bf16* WT, LAS float* scr, int item, int lane) {
    float tv[32]; tr_load(val, nblk, item, lane, tv); tr_store(tv, K, nblk, WT, scr, item, lane);
}
struct VWin { const float* w; __device__ __forceinline__ float operator()(int k, int n) const {
    if (n >= INC) return 0.f; const int i = n - 1920; const int src = (i < 0) ? n : 1920 + (i >> 1) + 16 * (i & 1); return w[(size_t)k * INC + src]; } };
struct VWuq { const float* w; const float* g; __device__ __forceinline__ float operator()(int k, int n) const {
    const int h = n / QKD, j = n - h * QKD, i = j - NOPE; const int src = (i < 0) ? n : h * QKD + NOPE + (i >> 1) + 16 * (i & 1); return w[(size_t)k * 768 + src] * g[k]; } };
struct VWukv { const float* w; const float* g; __device__ __forceinline__ float operator()(int k, int n) const { return k < KVLORA ? w[(size_t)k * 1024 + n] * g[k] : 0.f; } };
struct VWout { const float* w; const float* gs; const float* gm; __device__ __forceinline__ float operator()(int k, int n) const { return w[(size_t)k * 1024 + n] * (k < SBW ? gs[k] : gm[k - SBW]); } };
struct VWr { const float* wg; const float* we; const float* g; __device__ __forceinline__ float operator()(int k, int n) const {
    if (n < NGRP) return wg[(size_t)k * NGRP + n] * g[k]; if (n >= 128 && n < 128 + NEXP) return we[(size_t)k * NEXP + (n - 128)] * g[k]; return 0.f; } };
struct VWgu { const float* wgt; long long dlt  ; const float* g; __device__ __forceinline__ float operator()(int k, int n) const {
    const int hc = 4 * (n >> 3) + (n & 3); const float* w = (const float*)((uintptr_t)wgt + (uintptr_t)(((n >> 2) & 1) * dlt)); return w[(size_t)k * DEXP + hc] * g[k]; }
    __device__ __forceinline__ f32x4 v4(int k, int n) const {
        const float* w = (const float*)((uintptr_t)wgt + (uintptr_t)(((n >> 2) & 1) * dlt)); return *(const GAS f32x4*)(w + (size_t)k * DEXP + 4 * (n >> 3)) * g[k]; } };
struct VWd { const float* w; __device__ __forceinline__ float operator()(int k, int n) const { return w[(size_t)k * DM + n]; }
    __device__ __forceinline__ f32x4 v4(int k, int n) const { return *(const GAS f32x4*)(w + (size_t)k * DM + n); } };

struct Args { const void* in[20]; float* out; unsigned char* ws; int ph_lo, ph_hi, pad0, pad1; };
constexpr int NPHASE = 12;
__global__ void __launch_bounds__(NWAVES * 64, 2) fwd_kernel(Args args) {
    extern __shared__ __attribute__((aligned(16))) unsigned char lds_raw[];
    LAS unsigned char* lds = (LAS unsigned char*)lds_raw;
    volatile LAS unsigned* MISC = (volatile LAS unsigned*)(lds + MISC_OFF);
    const int tid = threadIdx.x, lane = tid & 63, wave = __builtin_amdgcn_readfirstlane(tid >> 6);
    const int G = gridDim.x, bx = blockIdx.x;
    const __attribute__((address_space(4))) Args* KA = (const __attribute__((address_space(4))) Args*)__builtin_amdgcn_kernarg_segment_ptr();
#define FIN(i) ((const float*)KA->in[i])
#define WSP(TY, off) ((TY*)(KA->ws + (off)))
    gu32* ctl = (gu32*)WSP(unsigned char, WS_CTL);
    for (int u = tid; u < (LDS_BYTES - LDSCTL_OFF) / 4; u += NWAVES * 64) ((LAS unsigned*)(lds + LDSCTL_OFF))[u] = 0u;
    __syncthreads();
    const int lo = KA->ph_lo, hi = KA->ph_hi;
    const bool use_bar = (hi - lo) > 1;
    XcdBarrier bar; bar.bar = (unsigned*)(ctl + CW_BAR); bar.x = 0; bar.st = nullptr;
    if (use_bar) bar = xcd_barrier_post((unsigned*)(ctl + CW_BAR), MISC + 8);
#ifndef PH_MASK
#define PH_MASK 0xfff
#endif
#define IN(k) ((((PH_MASK) >> (k)) & 1) && lo <= (k) && (k) < hi)
#ifndef PROBE_PHASE
#define PROBE_PHASE -1
#endif
#ifndef ATT_SEL
#define ATT_SEL 3
#endif
#define REP(k) for (int rep_ = 0; rep_ < ((PROBE_PHASE) == (k) ? 2 : 1); ++rep_)
#define SEAM(k) do { if (IN(k) && IN((k) + 1)) xcd_barrier(bar); } while (0)
    const int gw = bx * NWAVES + wave, NGW = G * NWAVES;

    if (IN(0)) REP(0) {
        LAS float* scr = (LAS float*)(lds + RING_OFF + wave * 16384);
        constexpr int I_WIN = 16 * 64, I_WUQ = 4 * 24, I_WUKV = 2 * 32, I_WOUT = 16 * 32, I_WR = 16 * 8;
        constexpr int NITEMS = I_WIN + I_WUQ + I_WUKV + I_WOUT + I_WR;
        for (int it = gw; it < NITEMS; it += NGW) {
            int r = it;
            if (r < I_WIN) { tr_item(VWin{FIN(3)}, 1024, 64, WSP(bf16, WS_WIN), scr, r, lane); continue; } r -= I_WIN;
            if (r < I_WUQ) { tr_item(VWuq{FIN(5), FIN(4)}, 256, 24, WSP(bf16, WS_WUQ), scr, r, lane); continue; } r -= I_WUQ;
            if (r < I_WUKV) { tr_item(VWukv{FIN(7), FIN(6)}, 128, 32, WSP(bf16, WS_WUKV), scr, r, lane); continue; } r -= I_WUKV;
            if (r < I_WOUT) { tr_item(VWout{FIN(10), FIN(8), FIN(9)}, 1024, 32, WSP(bf16, WS_WOUT), scr, r, lane); continue; } r -= I_WOUT;
            tr_item(VWr{FIN(12), FIN(14), FIN(11)}, 1024, 8, WSP(bf16, WS_WR), scr, r, lane);
        }
        { const float* x = FIN(0); bf16* H = WSP(bf16, WS_H); float* INV1 = WSP(float, WS_INV1); f32x4 gn[4];
#pragma unroll
          for (int j = 0; j < 4; ++j) gn[j] = *((const GAS f32x4*)FIN(2) + lane + 64 * j);
          for (int m = gw; m < T; m += 4 * NGW) {
              f32x4 v[4][4]; float s2[4];
#pragma unroll
              for (int r = 0; r < 4; ++r) { const GAS f32x4* xr = (const GAS f32x4*)(x + (size_t)(m + r * NGW) * DM) + lane;
#pragma unroll
                  for (int j = 0; j < 4; ++j) v[r][j] = __builtin_nontemporal_load(xr + 64 * j); }
#pragma unroll
              for (int r = 0; r < 4; ++r) { float s = 0.f;
#pragma unroll
                  for (int j = 0; j < 4; ++j) s += (v[r][j].x * v[r][j].x + v[r][j].y * v[r][j].y) + (v[r][j].z * v[r][j].z + v[r][j].w * v[r][j].w);
                  s2[r] = s; }
#pragma unroll
              for (int o = 1; o < 64; o <<= 1) {
#pragma unroll
                  for (int r = 0; r < 4; ++r) s2[r] += __shfl_xor(s2[r], o); }
#pragma unroll
              for (int r = 0; r < 4; ++r) { const float var = s2[r] * (1.f / DM) + EPS; const float rstd = rsqrtf(var); if (lane == 0) INV1[m + r * NGW] = sqrtf(var);
                  GAS unsigned long long* o8 = (GAS unsigned long long*)(H + (size_t)(m + r * NGW) * DM) + lane;
#pragma unroll
                  for (int j = 0; j < 4; ++j) { const f32x4 y = v[r][j] * rstd * gn[j]; o8[64 * j] = (unsigned long long)pg8::cvt_pk_bf16(y.x, y.y) | ((unsigned long long)pg8::cvt_pk_bf16(y.z, y.w) << 32); } }
          } }
        { const int* positions = (const int*)KA->in[1]; unsigned* TAB = WSP(unsigned, WS_TAB);
          for (int idx = bx * (NWAVES * 64) + tid; idx < T * 16; idx += G * NWAVES * 64) {
            const int tok = idx >> 4, i = idx & 15;
            const double invd = ((i & 1) ? 0.56234132519034908039 : 1.0) * ((i & 2) ? 0.31622776601683793320 : 1.0) * ((i & 4) ? 0.1 : 1.0) * ((i & 8) ? 0.01 : 1.0);
            const double ang = (double)positions[tok] * invd;
            const double kq = rint(ang * 0.63661977236758134308);
            const double rr = fma(-kq, 1.57079632679489661923, ang) - kq * 6.123233995736766e-17;
            const float r = (float)rr, r2 = r * r;
            const float sn = r + r * r2 * (-1.6666667163e-01f + r2 * (8.3333337680e-03f + r2 * (-1.9841270114e-04f + r2 * 2.7557314297e-06f)));
            const float cs = 1.0f + r2 * (-0.5f + r2 * (4.1666667908e-02f + r2 * (-1.3888889225e-03f + r2 * (2.4801587642e-05f + r2 * -2.7557314297e-07f))));
            const int q = (int)((long long)kq & 3);
            const float c = (q == 0) ? cs : (q == 1) ? -sn : (q == 2) ? -cs : sn;
            const float s = (q == 0) ? sn : (q == 1) ? cs : (q == 2) ? -sn : -cs;
            TAB[idx] = pk2(c, s);
          } }
    }
    SEAM(0);
    if (IN(1)) REP(1) {
        pg8::Gemm g{WSP(bf16, WS_H), WSP(bf16, WS_WIN), T, INP, DM, nullptr}; pg8::StaticOrder S; S.init(T, INP, G, bx);
        epi::EpiProj E{WSP(bf16, WS_QS), WSP(bf16, WS_CQ), WSP(bf16, WS_CKV), WSP(bf16, WS_KROPE), WSP(float, WS_SSQQ), WSP(float, WS_SSQKV), WSP(unsigned, WS_TAB)};
        pg8::gemm_phase<epi::EpiProj, pg8::StaticOrder, true, false>(lds + RING_OFF, g, S, E);
    }
    SEAM(1);
    if (IN(2)) REP(2) {
#ifndef P2SEL
#define P2SEL 3
#endif
        if (P2SEL & 1) { pg8::Gemm g{WSP(bf16, WS_CQ), WSP(bf16, WS_WUQ), T, 768, 256, nullptr}; pg8::StaticOrder S; S.init(T, 768, G, bx);
          epi::EpiQup E{WSP(bf16, WS_QM), WSP(float, WS_SSQQ), WSP(unsigned, WS_TAB)};
          pg8::gemm_phase<epi::EpiQup, pg8::StaticOrder, true, false>(lds + RING_OFF, g, S, E); }
        if (P2SEL & 2) { pg8::Gemm g{WSP(bf16, WS_CKV), WSP(bf16, WS_WUKV), T, 1024, 128, nullptr};   pg8::StaticOrder S; S.init(T, 1024, G, bx);
          epi::EpiKVup E{WSP(bf16, WS_KVM), WSP(float, WS_SSQKV)};
          pg8::gemm_phase<epi::EpiKVup, pg8::StaticOrder, true, false>(lds + RING_OFF, g, S, E); }
    }
    SEAM(2);
    if (IN(3)) {
        { const att::Tensors TS{WSP(bf16, WS_QS), 512, 64, WSP(bf16, WS_KS), 512, 64, nullptr, WSP(bf16, WS_VS), 512, 64, WSP(bf16, WS_O), 0, WSP(float, WS_OSS), 0};
#ifndef XW_REPS
#define XW_REPS 1
#endif
          const int xw_at = 7 - ((bx >> 3) & 7);
          for (int u = bx; u < BATCH * NH; u += G)
              if (ATT_SEL & 1) REP(30) { int lo = 1 << 20; for (int qb = 7; qb >= 0; --qb) {
                  if (qb == xw_at && u == bx) {
                      LAS float* scr = (LAS float*)(lds + RING_OFF + 4096 + wave * 16384);
                      for (int xrep_ = 0; xrep_ < XW_REPS; ++xrep_)
                      { int lane_x = threadIdx.x & 63; asm volatile("" : "+v"(lane_x));
#define lane lane_x
                      { const XwSrc XS{(uintptr_t)FIN(16), (long long)((uintptr_t)FIN(17) - (uintptr_t)FIN(16)), (uintptr_t)FIN(18), (uintptr_t)FIN(11), (uintptr_t)WSP(bf16, WS_WGU), (uintptr_t)WSP(bf16, WS_WD)};
                        f32x4 a0[8], b0[8], c0[8], d0[8]; float ag[8], bg[8], cg[8], dg[8];
#define XI(n) ((base + (n) * NGW) < XW_NI ? (base + (n) * NGW) : XW_NI - 1)
                        for (int base = gw; base < XW_NI; base += 6 * NGW) {
                            xw_load(XS, XI(0), lane, a0, ag); xw_load(XS, XI(1), lane, b0, bg); xw_load(XS, XI(2), lane, c0, cg);
                            xw_load(XS, XI(3), lane, d0, dg); xw_store(XS, XI(0), lane, scr, a0, ag);
                            xw_load(XS, XI(4), lane, a0, ag); xw_store(XS, XI(1), lane, scr, b0, bg);
                            xw_load(XS, XI(5), lane, b0, bg); xw_store(XS, XI(2), lane, scr, c0, cg);
                            xw_store(XS, XI(3), lane, scr, d0, dg); xw_store(XS, XI(4), lane, scr, a0, ag); xw_store(XS, XI(5), lane, scr, b0, bg);
                        } }
#undef XI
#undef lane
                      }
                      lo = 1 << 20; __syncthreads();
                  }
                  att::sb_unit(lds + RING_OFF, u, qb, TS, lo); } } }
        { bf16* KVM = WSP(bf16, WS_KVM);
          const att::Tensors TM{WSP(bf16, WS_QM), 768, 96, KVM, 1024, 128, WSP(bf16, WS_KROPE), KVM + 64, 1024, 128, WSP(bf16, WS_O), 512, WSP(float, WS_OSS), 8};
          for (int u = bx; u < BATCH * NH; u += G)
              if (ATT_SEL & 2) REP(31) for (int qb = 3; qb >= 0; --qb) att::attn_unit<1>(lds + RING_OFF, u, qb, TM, qb != 3, qb != 0); }
    }
    SEAM(3);
    if (IN(5)) REP(5) {
        pg8::Gemm g{WSP(bf16, WS_O), WSP(bf16, WS_WOUT), T, DM, DM, nullptr}; pg8::StaticOrder S; S.init(T, DM, G, bx);
        epi::EpiX1 E{WSP(bf16, WS_H), FIN(2), WSP(bf16, WS_X1B), WSP(float, WS_SSQ2), WSP(float, WS_OSS), WSP(float, WS_INV1), (LAS float*)(lds + LDSCTL_OFF + 1024)};
        pg8::gemm_phase<epi::EpiX1, pg8::StaticOrder, true, false>(lds + RING_OFF, g, S, E);
    }
    SEAM(5);
    if (IN(6)) REP(6) {
        pg8::Gemm g{WSP(bf16, WS_X1B), WSP(bf16, WS_WR), T, 256, DM, nullptr}; pg8::StaticOrder S; S.init(T, 256, G, bx);
        LAS int* ebuf = (LAS int*)(lds + LDSCTL_OFF + 1024); LAS int* wcnt = (LAS int*)(lds + LDSCTL_OFF + 1024 + 2048);
        int* EIDX = WSP(int, WS_EIDX); int* RANK = WSP(int, WS_RANK); int* CNT = WSP(int, WS_CNT);
        epi::EpiRouter E{WSP(float, WS_SSQ2), WSP(float, WS_RSTD2), FIN(13), FIN(15), EIDX, WSP(float, WS_EW), ebuf};
        pg8::Unit u;
        for (int i = 0; S.next(i, u); ++i) {
            epi::OneUnit S1{u};
            pg8::gemm_phase<epi::EpiRouter, epi::OneUnit, true, false>(lds + RING_OFF, g, S1, E);
            __syncthreads();
            const int ch = u.pm; int tq = tid; asm volatile("" : "+v"(tq));
            int e0 = -1, e1 = -1;
            if (tq < 256) { e0 = ebuf[tq * 2]; e1 = ebuf[tq * 2 + 1]; }
            int rk0 = 0, rk1 = 0;
            const unsigned long long ltm = (1ull << lane) - 1ull;
            for (int e = 0; e < NEXP; ++e) {
                const unsigned long long k0 = __ballot(e0 == e), k1 = __ballot(e1 == e);
                if (e0 == e) rk0 = __popcll(k0 & ltm);
                if (e1 == e) rk1 = __popcll(k1 & ltm);
                if (lane == 0 && wave < 4) { wcnt[(wave * 2 + 0) * 32 + e] = __popcll(k0); wcnt[(wave * 2 + 1) * 32 + e] = __popcll(k1); }
            }
            __syncthreads();
            if (tq < 256) {
                int b0 = 0, b1 = 0;
                for (int sg = 0; sg < wave * 2; ++sg) { b0 += wcnt[sg * 32 + e0]; b1 += wcnt[sg * 32 + e1]; }
                b1 += wcnt[(wave * 2) * 32 + e1];
                const int tok = ch * 256 + tq; RANK[tok * 2] = b0 + rk0; RANK[tok * 2 + 1] = b1 + rk1;
            }
            if (tq < 32) { int sm = 0; for (int sg = 0; sg < 8; ++sg) sm += wcnt[sg * 32 + tq]; CNT[ch * 32 + tq] = sm; }
            __syncthreads();
        }
    }
    SEAM(6);
    if (IN(8)) REP(8) {
        int tq = tid; asm volatile("" : "+v"(tq));
        LAS int* tot = (LAS int*)(lds + RING_OFF); LAS int* pbase = tot + 32; LAS int* mybase = tot + 72;
        const int* EIDX = WSP(int, WS_EIDX); const float* EW = WSP(float, WS_EW); const int* RANK = WSP(int, WS_RANK); const int* CNT = WSP(int, WS_CNT);
        int* TILEE = WSP(int, WS_TILEE); int* SLOTTOK = WSP(int, WS_SLOTTOK); float* SLOTW = WSP(float, WS_SLOTW); float* SLOTRS = WSP(float, WS_SLOTRS); const float* RSTD2 = WSP(float, WS_RSTD2);
        for (int ch = bx; ch < T / 256; ch += G) {
            { LAS int* part = tot + 128;
              const int e = tq & 31, cg = tq >> 5; int t = 0, mb = 0;
#pragma unroll
              for (int i = 0; i < 16; ++i) { const int c = cg * 16 + i; const int v = CNT[c * 32 + e]; t += v; mb += (c < ch) ? v : 0; }
              part[(cg * 2 + 0) * 32 + e] = t; part[(cg * 2 + 1) * 32 + e] = mb;
              __syncthreads();
              if (tq < 32) { int ts = 0, ms = 0;
#pragma unroll
                  for (int g = 0; g < 16; ++g) { ts += part[(g * 2 + 0) * 32 + tq]; ms += part[(g * 2 + 1) * 32 + tq]; }
                  tot[tq] = ts; mybase[tq] = ms; } }
            __syncthreads();
            if (tq == 0) { int pb = 0; for (int e = 0; e < NEXP; ++e) { pbase[e] = pb; pb += ((tot[e] + 255) >> 8) << 8; } pbase[32] = pb; }
            __syncthreads();
            if (tq < 256) { const int tok = ch * 256 + tq; const float rs2 = RSTD2[tok];
#pragma unroll
                for (int k = 0; k < 2; ++k) { const int e = EIDX[tok * 2 + k]; const int slot = pbase[e] + mybase[e] + RANK[tok * 2 + k]; SLOTTOK[slot] = tok * 2 + k; SLOTRS[slot] = rs2; SLOTW[slot] = EW[tok * 2 + k]; } }
            if (ch < NEXP) { const int e = ch; const int endp = pbase[e] + (((tot[e] + 255) >> 8) << 8);
                for (int s = pbase[e] + tot[e] + tq; s < endp; s += NWAVES * 64) { SLOTTOK[s] = -1; SLOTW[s] = 0.f; SLOTRS[s] = 0.f; } }
            if (ch == 0) { if (tq < 32) { const int nte = (tot[tq] + 255) >> 8; for (int tl = 0; tl < nte; ++tl) TILEE[(pbase[tq] >> 8) + tl] = tq; }
                           if (tq == 0) TILEE[MAXTILES] = pbase[32] >> 8; }
            __syncthreads();
        }
    }
    SEAM(8);
    if (IN(9)) REP(9) {
        const int* TILEE = WSP(int, WS_TILEE); const int* SLOTTOK = WSP(int, WS_SLOTTOK);
        const int ntiles = TILEE[MAXTILES]; const int n6 = ntiles * 2, full = (n6 / G) * G;
        pg8::Gemm g{WSP(bf16, WS_X1B), WSP(bf16, WS_WGU), T, 512, DM, SLOTTOK}; epi::MoeOrder S{TILEE, ntiles, 2, G, bx, full};
        epi::EpiGateUp E{WSP(float, WS_SLOTRS), WSP(bf16, WS_HID)};
        pg8::gemm_phase<epi::EpiGateUp, epi::MoeOrder, true, true>(lds + RING_OFF, g, S, E);
    }
    SEAM(9);
    if (IN(10)) REP(10) {
        const int* TILEE = WSP(int, WS_TILEE);
        const int ntiles = TILEE[MAXTILES]; const int n6 = ntiles * 2, full = (n6 / G) * G, nlate = n6 - full, tile0 = full >> 1;
        unsigned* lcnt = (unsigned*)(ctl + CW_LATE);
        if (bx < nlate) {
            const int L6 = full + bx; pg8::Unit u; u.pm = L6 >> 1; u.pn = TILEE[L6 >> 1] * 2 + (L6 & 1);
            pg8::Gemm g{WSP(bf16, WS_X1B), WSP(bf16, WS_WGU), T, 512, DM, WSP(int, WS_SLOTTOK)}; epi::OneUnit S1{u};
            epi::EpiGateUp E{WSP(float, WS_SLOTRS), WSP(bf16, WS_HID)};
            pg8::gemm_phase<epi::EpiGateUp, epi::OneUnit, true, true>(lds + RING_OFF, g, S1, E);
            asm volatile("s_waitcnt vmcnt(0)" ::: "memory"); __syncthreads();
            if (tid == 0) { __builtin_amdgcn_fence(__ATOMIC_RELEASE, "agent"); asm volatile("s_waitcnt vmcnt(0)" ::: "memory");
                __hip_atomic_fetch_add(lcnt + 64 * ((L6 >> 1) - tile0), 1u, __ATOMIC_RELAXED, __HIP_MEMORY_SCOPE_AGENT); }
        }
        pg8::Gemm g{WSP(bf16, WS_HID), WSP(bf16, WS_WD), MAXTILES * 256, 1024, DEXP, nullptr};
        epi::LateOrder S{TILEE, ntiles, G, bx, nlate, tile0, lcnt, (unsigned*)(ctl + CW_LATE_TMO)};
        epi::EpiDown E{WSP(int, WS_SLOTTOK), WSP(float, WS_SLOTW), WSP(unsigned char, WS_YB)};
        pg8::gemm_phase<epi::EpiDown, epi::LateOrder, true, false>(lds + RING_OFF, g, S, E);
    }
    SEAM(10);
    if (IN(11)) REP(11) {
        const bf16* X1B = WSP(bf16, WS_X1B); const unsigned char* YB = WSP(unsigned char, WS_YB); float* outp = KA->out;
        f32x4 gn[4];
#pragma unroll
        for (int j = 0; j < 4; ++j) gn[j] = *((const GAS f32x4*)FIN(19) + lane + 64 * j);
        for (int m = gw; m < T; m += NGW) {
            const GAS u32x2v* xr = (const GAS u32x2v*)(X1B + (size_t)m * DM) + lane;
            const GAS unsigned* y0 = (const GAS unsigned*)(YB + (size_t)(2 * m) * DM) + lane; const GAS unsigned* y1 = (const GAS unsigned*)(YB + (size_t)(2 * m + 1) * DM) + lane;
            f32x4 v[4]; float s2 = 0.f;
#pragma unroll
            for (int j = 0; j < 4; ++j) { const u32x2v c = __builtin_nontemporal_load(xr + 64 * j); const int a = (int)__builtin_nontemporal_load(y0 + 64 * j), b = (int)__builtin_nontemporal_load(y1 + 64 * j);
                const f32x2v a0 = __builtin_amdgcn_cvt_pk_f32_fp8(a, false), a1 = __builtin_amdgcn_cvt_pk_f32_fp8(a, true), b0 = __builtin_amdgcn_cvt_pk_f32_fp8(b, false), b1 = __builtin_amdgcn_cvt_pk_f32_fp8(b, true);
                v[j].x = bflo(c.x) + (a0.x + b0.x) * (1.0f / YB_SCALE); v[j].y = bfhi(c.x) + (a0.y + b0.y) * (1.0f / YB_SCALE); v[j].z = bflo(c.y) + (a1.x + b1.x) * (1.0f / YB_SCALE); v[j].w = bfhi(c.y) + (a1.y + b1.y) * (1.0f / YB_SCALE);
                s2 += (v[j].x * v[j].x + v[j].y * v[j].y) + (v[j].z * v[j].z + v[j].w * v[j].w); }
            const float rstd = rsqrtf(wave_sum(s2) * (1.f / DM) + EPS);
            GAS f32x4* orow = (GAS f32x4*)(outp + (size_t)m * DM) + lane;
#pragma unroll
            for (int j = 0; j < 4; ++j) orow[64 * j] = v[j] * rstd * gn[j];
        }
    }
#undef IN
#undef SEAM
}

#ifndef MK_N_LAUNCHES
#define MK_N_LAUNCHES 1
#endif
extern "C" void kernel_launch(void* const* d_in, const int* in_sizes, int n_in, void* d_out, int out_size, void* d_ws, size_t ws_size, hipStream_t stream) {
    static int grid = 0;
    if (grid == 0) {
        if (n_in != 20 || in_sizes[0] != T * DM || out_size != T * DM || ws_size < WS_END) { fprintf(stderr, "kernel_launch: unexpected shapes (n_in %d, in0 %d, out %d, ws %zu)\n", n_in, n_in > 0 ? in_sizes[0] : -1, out_size, ws_size); grid = -1; return; }
        int dev = 0, cus = 0, per_cu = 0;
        if (hipGetDevice(&dev) != hipSuccess || hipDeviceGetAttribute(&cus, hipDeviceAttributeMultiprocessorCount, dev) != hipSuccess) { grid = -1; return; }
        if (hipFuncSetAttribute((const void*)fwd_kernel, hipFuncAttributeMaxDynamicSharedMemorySize, LDS_BYTES) != hipSuccess) { fprintf(stderr, "kernel_launch: hipFuncSetAttribute failed\n"); grid = -1; return; }
        if (hipOccupancyMaxActiveBlocksPerMultiprocessor(&per_cu, (const void*)fwd_kernel, NWAVES * 64, LDS_BYTES) != hipSuccess || per_cu < 1) { fprintf(stderr, "kernel_launch: occupancy query reports %d blocks per CU\n", per_cu); }
        (void)hipGetLastError();
        grid = cus;
    }
    if (grid < 0) return;
    if (hipMemsetAsync((char*)d_ws + WS_CTL, 0, CTL_ZERO_BYTES, stream) != hipSuccess) return;
    Args a{};
    for (int i = 0; i < 20; ++i) a.in[i] = d_in[i];
    a.out = (float*)d_out; a.ws = (unsigned char*)d_ws;
    if (MK_N_LAUNCHES == 1) { a.ph_lo = 0; a.ph_hi = NPHASE; hipLaunchKernelGGL(fwd_kernel, dim3(grid), dim3(NWAVES * 64), LDS_BYTES, stream, a); }
    else for (int p = 0; p < NPHASE; ++p) { a.ph_lo = p; a.ph_hi = p + 1; hipLaunchKernelGGL(fwd_kernel, dim3(grid), dim3(NWAVES * 64), LDS_BYTES, stream, a); }
}
```
